# Optimizing an MI355X kernel written in HIP

```python
import math
import jax, jax.numpy as jnp
from jax import lax
import numpy as np

D_MODEL = 1024
BATCH = 8
SEQ = 2048
DEPTH = 2

CTX_LEN = 256
GRID_W = 64
EPS = 1e-6
F32 = jnp.float32

HY_WIDTH = D_MODEL // 2
HY_ORDER = 2
HY_IN = (HY_ORDER + 1) * HY_WIDTH
HY_SHORT = 3
HY_BANDS = 16
HY_EMB = 2 * HY_BANDS + 1
HY_HIDDEN = 64
HY_DECAY_SLOW = -math.log(1e-2) / 1.5
HY_DECAY_FAST = -math.log(1e-2) / 0.3
HEAD_DIM = 64
N_Q_HEADS = (D_MODEL // 2) // HEAD_DIM
N_KV_HEADS = N_Q_HEADS // 4
Q_PER_KV = N_Q_HEADS // N_KV_HEADS
ATTN_WIDTH = N_Q_HEADS * HEAD_DIM
KV_WIDTH = N_KV_HEADS * HEAD_DIM
IN_EVEN = HY_IN + ATTN_WIDTH + 2 * KV_WIDTH
MIX_EVEN = HY_WIDTH + ATTN_WIDTH
ROPE_THETA = 10000.0
Q_BLOCK = 128
D_FF = 256 * ((8 * D_MODEL // 3 + 255) // 256)

S5_WIDTH = D_MODEL
S5_GROUP = 16
S5_GROUPS = S5_WIDTH // S5_GROUP
S5_STATE = 64
S5_DT_MIN = 1e-3
S5_DT_MAX = 1e-1
N_EXPERTS = 8
TOP_K = 2
D_FF_EXPERT = 7 * D_MODEL // 2

N_EVEN = (DEPTH + 1) // 2
N_ODD = DEPTH // 2

kernel_name = 'hybrid_hyena_gqa_s5_moe_dit'


def rms_norm(x, gain):
    xf = x.astype(F32)
    xf = xf * lax.rsqrt(jnp.mean(xf * xf, axis=-1, keepdims=True) + EPS)
    return (xf * gain.astype(F32)).astype(x.dtype)


def ada_params(cond, w, b):
    m = jax.nn.silu(cond) @ w + b
    m = m.reshape(m.shape[:-1] + (1, 6, D_MODEL))
    return tuple(m[..., k, :] for k in range(6))


def modulate(h, shift, scale):
    return h * (1.0 + scale) + shift


def centred_short_conv(u, w, b):
    L = u.shape[1]
    pad = HY_SHORT // 2
    up = jnp.pad(u, ((0, 0), (pad, pad), (0, 0)))
    y = b
    for k in range(HY_SHORT):
        y = y + up[:, k:k + L] * w[k]
    return y


def hyena_filters(L, w1, b1, w2, b2, wout, freq):
    t = jnp.linspace(0.0, 1.0, L, dtype=F32)[:, None]
    bands = jnp.linspace(1e-4, HY_BANDS - 1, HY_BANDS, dtype=F32)
    phase = (2.0 * math.pi / L) * jnp.arange(L, dtype=F32)[:, None] * bands
    z = jnp.concatenate([t, jnp.cos(phase), -jnp.sin(phase)], axis=-1)
    fr = freq.astype(F32)
    h = jnp.sin(fr * (z @ w1.astype(F32) + b1.astype(F32)))
    h = jnp.sin(fr * (h @ w2.astype(F32) + b2.astype(F32)))
    h = (h @ wout.astype(F32)).reshape(L, 2, HY_ORDER, HY_WIDTH)
    deltas = jnp.linspace(HY_DECAY_SLOW, HY_DECAY_FAST, HY_WIDTH, dtype=F32)
    decay = jnp.exp(-t * deltas)
    return h * decay[:, None, None, :]


def two_sided_fftconv(u, h2, skip):
    L, C = u.shape[1], u.shape[2]
    k = jnp.concatenate([h2[:, 0], jnp.zeros((1, C), F32), h2[:0:-1, 1]], axis=0)
    kf = jnp.fft.rfft(k, axis=0)
    uf = jnp.fft.rfft(u.astype(F32), n=2 * L, axis=1)
    y = jnp.fft.irfft(uf * kf, n=2 * L, axis=1)[:, :L]
    return (y + u.astype(F32) * skip.astype(F32)).astype(u.dtype)


def hyena_mixer(p, filt, conv_w, conv_b, skip):
    z = centred_short_conv(p, conv_w, conv_b)
    parts = jnp.split(z, HY_ORDER + 1, axis=-1)
    v = parts[0]
    for o in range(HY_ORDER):
        v = parts[o + 1] * two_sided_fftconv(v, filt[:, :, o], skip[o])
    return v


def axial_rope(L):
    rows = L // GRID_W
    row = jnp.repeat(jnp.arange(rows, dtype=F32), GRID_W)
    col = jnp.tile(jnp.arange(GRID_W, dtype=F32), rows)
    n_freq = HEAD_DIM // 4
    inv = ROPE_THETA ** (-jnp.arange(n_freq, dtype=F32) / n_freq)
    ang = jnp.concatenate([row[:, None] * inv, col[:, None] * inv], axis=-1)
    return jnp.cos(ang), jnp.sin(ang)


def apply_rope(x, cos, sin):
    xf = x.astype(F32)
    x1, x2 = jnp.split(xf, 2, axis=-1)
    c = cos[None, :, None, :]
    s = sin[None, :, None, :]
    return jnp.concatenate([x1 * c - x2 * s, x1 * s + x2 * c], axis=-1).astype(x.dtype)


def gqa_core(q, k, v):
    s = jnp.einsum('bqhgd,bkhd->bhgqk', q, k).astype(F32) * (HEAD_DIM ** -0.5)
    p = jax.nn.softmax(s, axis=-1).astype(v.dtype)
    return jnp.einsum('bhgqk,bkhd->bqhgd', p, v)


def gqa_context(q, k, v):
    B, L = q.shape[:2]
    o = gqa_core(q.reshape(B, L, N_KV_HEADS, Q_PER_KV, HEAD_DIM), k, v)
    return o.reshape(B, L, ATTN_WIDTH)


def gqa_latent_blocked(q, k, v):
    B, L = q.shape[:2]
    nb = L // Q_BLOCK
    qb = q.reshape(B, nb, Q_BLOCK, N_KV_HEADS, Q_PER_KV, HEAD_DIM).transpose(1, 0, 2, 3, 4, 5)
    o = lax.map(lambda qi: gqa_core(qi, k, v), qb)
    return o.transpose(1, 0, 2, 3, 4, 5).reshape(B, L, ATTN_WIDTH)


def even_mixer(h_l, h_c, w_in, conv_w, conv_b, f_w1, f_b1, f_w2, f_b2, f_wout, f_freq, hy_skip,
               q_norm, k_norm, w_out, need_ctx):
    def project(h):
        B, L = h.shape[:2]
        p = h @ w_in
        hy = p[..., :HY_IN]
        q = p[..., HY_IN:HY_IN + ATTN_WIDTH].reshape(B, L, N_Q_HEADS, HEAD_DIM)
        k = p[..., HY_IN + ATTN_WIDTH:HY_IN + ATTN_WIDTH + KV_WIDTH].reshape(B, L, N_KV_HEADS, HEAD_DIM)
        v = p[..., HY_IN + ATTN_WIDTH + KV_WIDTH:].reshape(B, L, N_KV_HEADS, HEAD_DIM)
        return hy, rms_norm(q, q_norm), rms_norm(k, k_norm), v

    filt_args = (f_w1, f_b1, f_w2, f_b2, f_wout, f_freq)
    hy_c, q_c, k_c, v_c = project(h_c)
    hy_l, q_l, k_l, v_l = project(h_l)
    L = h_l.shape[1]
    cos, sin = axial_rope(L)
    q_l = apply_rope(q_l, cos, sin)
    k_l = apply_rope(k_l, cos, sin)
    y_hy_l = hyena_mixer(hy_l, hyena_filters(L, *filt_args), conv_w, conv_b, hy_skip)
    y_at_l = gqa_latent_blocked(q_l, jnp.concatenate([k_c, k_l], axis=1),
                                jnp.concatenate([v_c, v_l], axis=1))
    out_l = jnp.concatenate([y_hy_l, y_at_l], axis=-1) @ w_out
    out_c = None
    if need_ctx:
        y_hy_c = hyena_mixer(hy_c, hyena_filters(h_c.shape[1], *filt_args), conv_w, conv_b, hy_skip)
        y_at_c = gqa_context(q_c, k_c, v_c)
        out_c = jnp.concatenate([y_hy_c, y_at_c], axis=-1) @ w_out
    return out_l, out_c


def s5_discretise(lam_re, lam_im, log_step, b_re, b_im):
    lr = jnp.minimum(lam_re.astype(F32), -1e-4)
    li = lam_im.astype(F32)
    dt = jnp.exp(log_step.astype(F32))[:, None]
    mag = jnp.exp(lr * dt)
    ab_re = mag * jnp.cos(li * dt)
    ab_im = mag * jnp.sin(li * dt)
    den = lr * lr + li * li
    nr, ni = ab_re - 1.0, ab_im
    co_re = (nr * lr + ni * li) / den
    co_im = (ni * lr - nr * li) / den
    br, bi = b_re.astype(F32), b_im.astype(F32)
    bb_re = co_re[..., None] * br - co_im[..., None] * bi
    bb_im = co_re[..., None] * bi + co_im[..., None] * br
    return ab_re, ab_im, bb_re, bb_im


def s5_scan(bu_re, bu_im, ab_re, ab_im, s0_re, s0_im):
    bu_re = bu_re.at[:, 0].add(ab_re * s0_re - ab_im * s0_im)
    bu_im = bu_im.at[:, 0].add(ab_re * s0_im + ab_im * s0_re)
    L = bu_re.shape[1]
    a_re = jnp.broadcast_to(ab_re, (1, L) + ab_re.shape)
    a_im = jnp.broadcast_to(ab_im, (1, L) + ab_im.shape)

    def combine(e1, e2):
        a1r, a1i, b1r, b1i = e1
        a2r, a2i, b2r, b2i = e2
        return (a2r * a1r - a2i * a1i, a2r * a1i + a2i * a1r,
                a2r * b1r - a2i * b1i + b2r, a2r * b1i + a2i * b1r + b2i)

    _, _, s_re, s_im = lax.associative_scan(combine, (a_re, a_im, bu_re, bu_im), axis=1)
    return s_re, s_im


def s5_direction(u_c, u_l, lam_re, lam_im, log_step, b_re, b_im, c_re, c_im, need_ctx):
    ab_re, ab_im, bb_re, bb_im = s5_discretise(lam_re, lam_im, log_step, b_re, b_im)
    cr, ci = c_re.astype(F32), c_im.astype(F32)

    def drive(u):
        return (jnp.einsum('blgk,gnk->blgn', u, bb_re), jnp.einsum('blgk,gnk->blgn', u, bb_im))

    def readout(s_re, s_im):
        return jnp.einsum('blgn,gkn->blgk', s_re, cr) - jnp.einsum('blgn,gkn->blgk', s_im, ci)

    zero = jnp.zeros(u_c.shape[:1] + ab_re.shape, F32)
    sc_re, sc_im = s5_scan(*drive(u_c), ab_re, ab_im, zero, zero)
    sl_re, sl_im = s5_scan(*drive(u_l), ab_re, ab_im, sc_re[:, -1], sc_im[:, -1])
    y_l = readout(sl_re, sl_im)
    y_c = readout(sc_re, sc_im) if need_ctx else None
    return y_l, y_c


def s5_glu(y, w_a, w_b, dtype):
    z = jax.nn.gelu(y).astype(dtype)
    return (z @ w_a) * jax.nn.sigmoid(z @ w_b)


def odd_mixer(h_l, h_c, w_in, lam_re, lam_im, log_step, b_re, b_im, c_re, c_im, d_skip, w_a, w_b, need_ctx):
    B, L = h_l.shape[:2]
    Lc = h_c.shape[1]
    u_l = (h_l @ w_in).astype(F32)
    u_c = (h_c @ w_in).astype(F32)
    gl = u_l.reshape(B, L, S5_GROUPS, S5_GROUP)
    gc = u_c.reshape(B, Lc, S5_GROUPS, S5_GROUP)
    yf_l, yf_c = s5_direction(gc, gl, lam_re[0], lam_im[0], log_step[0], b_re[0], b_im[0],
                              c_re[0], c_im[0], need_ctx)
    yb_l, yb_c = s5_direction(gc[:, ::-1], gl[:, ::-1], lam_re[1], lam_im[1], log_step[1], b_re[1], b_im[1],
                              c_re[1], c_im[1], need_ctx)
    d = d_skip.astype(F32)
    y_l = (yf_l + yb_l[:, ::-1]).reshape(B, L, S5_WIDTH) + d * u_l
    out_l = s5_glu(y_l, w_a, w_b, h_l.dtype)
    out_c = None
    if need_ctx:
        y_c = (yf_c + yb_c[:, ::-1]).reshape(B, Lc, S5_WIDTH) + d * u_c
        out_c = s5_glu(y_c, w_a, w_b, h_c.dtype)
    return out_l, out_c


def dense_swiglu(h, w_gate, w_up, w_down):
    return (jax.nn.silu(h @ w_gate) * (h @ w_up)) @ w_down


def moe_swiglu(h, router, w_gate, w_up, w_down):
    shp = h.shape
    t = h.reshape(-1, D_MODEL)
    logits = (t @ router).astype(F32)
    top_val, top_idx = lax.top_k(logits, TOP_K)
    top_w = jax.nn.softmax(top_val, axis=-1)
    gates = jnp.sum(jax.nn.one_hot(top_idx, N_EXPERTS, dtype=F32) * top_w[..., None], axis=1)
    out = jnp.zeros_like(t)
    for e in range(N_EXPERTS):
        he = jax.nn.silu(t @ w_gate[e]) * (t @ w_up[e])
        out = out + gates[:, e:e + 1].astype(t.dtype) * (he @ w_down[e])
    return out.reshape(shp)


def setup_inputs(seed: int = 0) -> dict:
    key = jax.random.key(seed)
    ks = iter(jax.random.split(key, 64))

    def nrm(shape, scale):
        return jax.random.normal(next(ks), shape, F32) * scale

    def gain(shape):
        return 1.0 + nrm(shape, 0.01)

    g, n = S5_GROUPS, S5_STATE
    n_idx = jnp.arange(S5_STATE, dtype=F32)
    return {
        'x': nrm((BATCH, SEQ, D_MODEL), 1.0),
        'c': nrm((BATCH, D_MODEL), 1.0),
        'ctx': nrm((BATCH, CTX_LEN, D_MODEL), 1.0),
        'c_ctx': nrm((D_MODEL,), 1.0),
        'ada_w': nrm((DEPTH, D_MODEL, 6 * D_MODEL), 0.5 * D_MODEL ** -0.5),
        'ada_b': nrm((DEPTH, 6 * D_MODEL), 0.01),
        'norm_mix_pre': gain((DEPTH, D_MODEL)),
        'norm_mix_post': gain((DEPTH, D_MODEL)),
        'norm_ffn_pre': gain((DEPTH, D_MODEL)),
        'norm_ffn_post': gain((DEPTH, D_MODEL)),
        'ev_w_in': nrm((N_EVEN, D_MODEL, IN_EVEN), D_MODEL ** -0.5),
        'ev_hy_conv_w': nrm((N_EVEN, HY_SHORT, HY_IN), HY_SHORT ** -0.5),
        'ev_hy_conv_b': nrm((N_EVEN, HY_IN), 0.01),
        'ev_hy_f_w1': nrm((N_EVEN, HY_EMB, HY_HIDDEN), HY_EMB ** -0.5),
        'ev_hy_f_b1': nrm((N_EVEN, HY_HIDDEN), 0.01),
        'ev_hy_f_w2': nrm((N_EVEN, HY_HIDDEN, HY_HIDDEN), HY_HIDDEN ** -0.5),
        'ev_hy_f_b2': nrm((N_EVEN, HY_HIDDEN), 0.01),
        'ev_hy_f_wout': nrm((N_EVEN, HY_HIDDEN, 2 * HY_ORDER * HY_WIDTH), 0.02),
        'ev_hy_freq': gain((N_EVEN, HY_HIDDEN)),
        'ev_hy_skip': nrm((N_EVEN, HY_ORDER, HY_WIDTH), 0.5),
        'ev_q_norm': gain((N_EVEN, HEAD_DIM)),
        'ev_k_norm': gain((N_EVEN, HEAD_DIM)),
        'ev_w_out': nrm((N_EVEN, MIX_EVEN, D_MODEL), MIX_EVEN ** -0.5),
        'ev_ffn_w_gate': nrm((N_EVEN, D_MODEL, D_FF), D_MODEL ** -0.5),
        'ev_ffn_w_up': nrm((N_EVEN, D_MODEL, D_FF), D_MODEL ** -0.5),
        'ev_ffn_w_down': nrm((N_EVEN, D_FF, D_MODEL), D_FF ** -0.5),
        'od_w_in': nrm((N_ODD, D_MODEL, S5_WIDTH), D_MODEL ** -0.5),
        'od_s5_lambda_re': -0.5 + nrm((N_ODD, 2, g, n), 0.01),
        'od_s5_lambda_im': math.pi * n_idx + nrm((N_ODD, 2, g, n), 0.01),
        'od_s5_log_step': jax.random.uniform(next(ks), (N_ODD, 2, g), F32,
                                             math.log(S5_DT_MIN), math.log(S5_DT_MAX)),
        'od_s5_b_re': nrm((N_ODD, 2, g, n, S5_GROUP), (2 * S5_GROUP) ** -0.5),
        'od_s5_b_im': nrm((N_ODD, 2, g, n, S5_GROUP), (2 * S5_GROUP) ** -0.5),
        'od_s5_c_re': nrm((N_ODD, 2, g, S5_GROUP, n), S5_STATE ** -0.5),
        'od_s5_c_im': nrm((N_ODD, 2, g, S5_GROUP, n), S5_STATE ** -0.5),
        'od_s5_d': nrm((N_ODD, S5_WIDTH), 0.5),
        'od_glu_w_a': nrm((N_ODD, S5_WIDTH, D_MODEL), S5_WIDTH ** -0.5),
        'od_glu_w_b': nrm((N_ODD, S5_WIDTH, D_MODEL), S5_WIDTH ** -0.5),
        'od_router': nrm((N_ODD, D_MODEL, N_EXPERTS), D_MODEL ** -0.5),
        'od_moe_w_gate': nrm((N_ODD, N_EXPERTS, D_MODEL, D_FF_EXPERT), D_MODEL ** -0.5),
        'od_moe_w_up': nrm((N_ODD, N_EXPERTS, D_MODEL, D_FF_EXPERT), D_MODEL ** -0.5),
        'od_moe_w_down': nrm((N_ODD, N_EXPERTS, D_FF_EXPERT, D_MODEL), D_FF_EXPERT ** -0.5),
    }


def reference(x, c, ctx, c_ctx, ada_w, ada_b, norm_mix_pre, norm_mix_post, norm_ffn_pre, norm_ffn_post,
              ev_w_in, ev_hy_conv_w, ev_hy_conv_b, ev_hy_f_w1, ev_hy_f_b1, ev_hy_f_w2, ev_hy_f_b2,
              ev_hy_f_wout, ev_hy_freq, ev_hy_skip, ev_q_norm, ev_k_norm, ev_w_out,
              ev_ffn_w_gate, ev_ffn_w_up, ev_ffn_w_down,
              od_w_in, od_s5_lambda_re, od_s5_lambda_im, od_s5_log_step, od_s5_b_re, od_s5_b_im,
              od_s5_c_re, od_s5_c_im, od_s5_d, od_glu_w_a, od_glu_w_b,
              od_router, od_moe_w_gate, od_moe_w_up, od_moe_w_down):
    for i in range(DEPTH):
        last = i == DEPTH - 1
        j = i // 2
        sh_m, sc_m, g_m, sh_f, sc_f, g_f = ada_params(c, ada_w[i], ada_b[i])
        cm = ada_params(c_ctx, ada_w[i], ada_b[i])
        h_l = modulate(rms_norm(x, norm_mix_pre[i]), sh_m, sc_m)
        h_c = modulate(rms_norm(ctx, norm_mix_pre[i]), cm[0], cm[1])
        if i % 2 == 0:
            out_l, out_c = even_mixer(h_l, h_c, ev_w_in[j], ev_hy_conv_w[j], ev_hy_conv_b[j],
                                      ev_hy_f_w1[j], ev_hy_f_b1[j], ev_hy_f_w2[j], ev_hy_f_b2[j],
                                      ev_hy_f_wout[j], ev_hy_freq[j], ev_hy_skip[j],
                                      ev_q_norm[j], ev_k_norm[j], ev_w_out[j], not last)
            ffn = lambda h: dense_swiglu(h, ev_ffn_w_gate[j], ev_ffn_w_up[j], ev_ffn_w_down[j])
        else:
            out_l, out_c = odd_mixer(h_l, h_c, od_w_in[j], od_s5_lambda_re[j], od_s5_lambda_im[j],
                                     od_s5_log_step[j], od_s5_b_re[j], od_s5_b_im[j],
                                     od_s5_c_re[j], od_s5_c_im[j], od_s5_d[j],
                                     od_glu_w_a[j], od_glu_w_b[j], not last)
            ffn = lambda h: moe_swiglu(h, od_router[j], od_moe_w_gate[j], od_moe_w_up[j], od_moe_w_down[j])
        x = x + g_m * rms_norm(out_l, norm_mix_post[i])
        hf = modulate(rms_norm(x, norm_ffn_pre[i]), sh_f, sc_f)
        x = x + g_f * rms_norm(ffn(hf), norm_ffn_post[i])
        if not last:
            ctx = ctx + cm[2] * rms_norm(out_c, norm_mix_post[i])
            hf_c = modulate(rms_norm(ctx, norm_ffn_pre[i]), cm[3], cm[4])
            ctx = ctx + cm[5] * rms_norm(ffn(hf_c), norm_ffn_post[i])
    return x
```

```cpp
#include <hip/hip_runtime.h>
#include <cstdio>
#include <cstdint>

#define LAS __attribute__((address_space(3)))
#define GAS __attribute__((address_space(1)))
typedef unsigned short bf16_t;
typedef short bf16x8 __attribute__((ext_vector_type(8)));
typedef float f32x4 __attribute__((ext_vector_type(4)));
typedef float f32x2 __attribute__((ext_vector_type(2)));
typedef unsigned u32x4 __attribute__((ext_vector_type(4)));
typedef unsigned u32x2 __attribute__((ext_vector_type(2)));

constexpr int D = 1024, NB = 8, SEQ = 2048, CTX = 256;
constexpr int ML = NB * SEQ, MC = NB * CTX, MT = ML + MC;
constexpr int HYW = 512, HYIN = 1536, INEV = 2304, KVL = CTX + SEQ;
constexpr int DFF = 2816, NEXP = 8, DFE = 3584;
constexpr float EPS = 1e-6f;
constexpr float C2 = 0.125f * 1.4426950408889634f;
constexpr float DEC_SLOW = 3.0701134573253945f, DEC_FAST = 15.350567286626973f;
constexpr int NWAVES = 8, NTHR = 512;

constexpr size_t MiB = 1u << 20;
constexpr size_t WS_CTL = 0, CTL_ZERO_BYTES = 1 * MiB;
constexpr size_t WS_MOD = 1 * MiB;
constexpr size_t WS_S5AB = 1 * MiB + 512 * 1024;
constexpr size_t WS_S5BB = 2 * MiB;
constexpr size_t WS_ROUTE = 3 * MiB;
constexpr size_t WS_X1 = 6 * MiB;
constexpr size_t WS_XN = 78 * MiB;
constexpr size_t WS_ZTL = WS_X1;
constexpr size_t WS_ZTC = WS_X1 + 48 * MiB;
constexpr size_t WS_QB = WS_XN;
constexpr size_t WS_KB = WS_XN + 18 * MiB;
constexpr size_t WS_VB = WS_KB + 4 * MiB + 512 * 1024;
constexpr size_t AR = 114 * MiB;
constexpr size_t WS_W0IN = AR + 0;
constexpr size_t WS_W0OUT = AR + 4 * MiB + 512 * 1024;
constexpr size_t WS_W0GU = AR + 6 * MiB + 512 * 1024;
constexpr size_t WS_W0DN = AR + 17 * MiB + 512 * 1024;
constexpr size_t WS_W1IN = AR + 23 * MiB;
constexpr size_t WS_WGLU = AR + 25 * MiB;
constexpr size_t WS_KFL = AR + 29 * MiB;
constexpr size_t WS_KFC = AR + 45 * MiB;
constexpr size_t WS_R = AR + 47 * MiB;
constexpr size_t WS_P = AR + 119 * MiB;
constexpr size_t WS_Y = AR + 119 * MiB;
constexpr size_t WS_H = AR + 119 * MiB;
constexpr size_t WS_U = AR + 119 * MiB;
constexpr size_t WS_YF = AR + 47 * MiB;
constexpr size_t WS_YB = AR + 155 * MiB;
constexpr size_t WS_Z = WS_XN;
constexpr size_t WS_H2 = AR + 0;
constexpr size_t WS_WMGU = AR + 226 * MiB;
constexpr size_t WS_WMDN = AR + 338 * MiB;
constexpr size_t WS_Y2 = AR + 226 * MiB;
constexpr size_t WS_END = AR + 394 * MiB;
constexpr int CW_BAR = 4096;
constexpr int CW_CNT = 256;

struct Params { const float* in[41]; float* out; unsigned char* ws; int ph_lo, ph_hi; };
struct Frame { LAS unsigned char* lds; int tid, lane, wave, G, bid; };

enum { I_X = 0, I_C, I_CTX, I_CCTX, I_ADAW, I_ADAB, I_NMPRE, I_NMPOST, I_NFPRE, I_NFPOST, I_EVWIN, I_CONVW, I_CONVB, I_FW1, I_FB1, I_FW2, I_FB2, I_FWOUT, I_FREQ,
       I_SKIP, I_QN, I_KN, I_EVWOUT, I_FFG, I_FFU, I_FFD, I_ODWIN, I_LRE, I_LIM, I_LSTEP, I_BRE, I_BIM, I_CRE, I_CIM, I_S5D, I_GLUA, I_GLUB, I_ROUTER, I_MG, I_MU, I_MD };

__device__ __forceinline__ float bf2f(unsigned h) { return __uint_as_float(h << 16); }
__device__ __forceinline__ unsigned f2bf(float f) { unsigned u = __float_as_uint(f); return (u + 0x7fffu + ((u >> 16) & 1u)) >> 16; }
__device__ __forceinline__ unsigned pk2(float lo, float hi) { return f2bf(lo) | (f2bf(hi) << 16); }
__device__ __forceinline__ float wave_sum(float v) {
#pragma unroll
    for (int o = 1; o < 64; o <<= 1) v += __shfl_xor(v, o);
    return v;
}
__device__ __forceinline__ float sigmoidf_(float x) { return 1.f / (1.f + __expf(-x)); }
__device__ __forceinline__ float siluf_(float x) { return x / (1.f + __expf(-x)); }
__device__ __forceinline__ float gelu_tanh(float x) { const float u = 0.7978845608028654f * (x + 0.044715f * x * x * x); const float t = 1.f - 2.f / (1.f + __expf(2.f * u)); return 0.5f * x * (1.f + t); }
__device__ __forceinline__ void unpack8(u32x4 r, float* v) {
    v[0] = bf2f(r.x & 0xffffu); v[1] = bf2f(r.x >> 16); v[2] = bf2f(r.y & 0xffffu); v[3] = bf2f(r.y >> 16);
    v[4] = bf2f(r.z & 0xffffu); v[5] = bf2f(r.z >> 16); v[6] = bf2f(r.w & 0xffffu); v[7] = bf2f(r.w >> 16);
}
__device__ __forceinline__ u32x4 pack8(const float* v) { u32x4 r; r.x = pk2(v[0], v[1]); r.y = pk2(v[2], v[3]); r.z = pk2(v[4], v[5]); r.w = pk2(v[6], v[7]); return r; }

struct TD { const float* src; bf16_t* dst; int K, N, mode, start; };
__device__ __forceinline__ void p0_transpose_item(const float* W, int K, int N, bf16_t* WT, int mode, LAS float* scr, int item, int lane) {
    const int nblk = N / 32, kb = item / nblk, nb = item % nblk, k0 = 64 * kb, n0 = 32 * nb;
    const int drow0 = (mode == 0) ? n0 : (256 * (n0 / 128) + (n0 % 128) + (mode == 2 ? 128 : 0));
#pragma unroll 8
    for (int i = 0; i < 32; ++i) { const int kk = 2 * i + (lane >> 5); scr[kk * 33 + (lane & 31)] = W[(size_t)(k0 + kk) * N + n0 + (lane & 31)]; }
    asm volatile("s_waitcnt lgkmcnt(0)" ::: "memory");
    const int c = lane & 7;
#pragma unroll
    for (int j = 0; j < 4; ++j) { const int n = (lane >> 3) + 8 * j; const LAS float* s = scr + (8 * c) * 33 + n;
        u32x4 o; o.x = pk2(s[0 * 33], s[1 * 33]); o.y = pk2(s[2 * 33], s[3 * 33]); o.z = pk2(s[4 * 33], s[5 * 33]); o.w = pk2(s[6 * 33], s[7 * 33]);
        *(u32x4*)(WT + (size_t)(drow0 + n) * K + k0 + 8 * c) = o; }
    asm volatile("s_waitcnt lgkmcnt(0)" ::: "memory");
}

__device__ __forceinline__ void phase_p0a(const Params& p, Frame& F) {
    unsigned char* ws = p.ws;
    {
        LAS float* sc = (LAS float*)F.lds;
        LAS float* red = (LAS float*)(F.lds + 36864);
        const float* c = p.in[I_C]; const float* cc = p.in[I_CCTX];
        for (int i = F.tid; i < 9 * 1024; i += NTHR) { const int r = i >> 10, k = i & 1023; const float v = r < 8 ? c[r * 1024 + k] : cc[k]; sc[i] = siluf_(v); }
        __syncthreads();
        float* MOD = (float*)(ws + WS_MOD);
        for (int it = F.bid; it < 192; it += F.G) {
            const int l = it / 96, n0 = (it % 96) * 64;
            const float* W = p.in[I_ADAW] + (size_t)l * 1024 * 6144 + n0 + F.lane;
            float acc[9];
#pragma unroll
            for (int r = 0; r < 9; ++r) acc[r] = 0.f;
            const int k0 = F.wave * 128;
#pragma unroll 8
            for (int k = 0; k < 128; ++k) { const float w = W[(size_t)(k0 + k) * 6144];
#pragma unroll
                for (int r = 0; r < 9; ++r) acc[r] += sc[r * 1024 + k0 + k] * w; }
#pragma unroll
            for (int r = 0; r < 9; ++r) red[(F.wave * 9 + r) * 64 + F.lane] = acc[r];
            __syncthreads();
            for (int o = F.tid; o < 576; o += NTHR) { const int r = o >> 6, ln = o & 63; float s = p.in[I_ADAB][l * 6144 + n0 + ln];
#pragma unroll
                for (int w = 0; w < 8; ++w) s += red[(w * 9 + r) * 64 + ln];
                MOD[(size_t)(l * 9 + r) * 6144 + n0 + ln] = s; }
            __syncthreads();
        }
    }
    {
        LAS float* h1 = (LAS float*)F.lds; LAS float* h2 = h1 + 1024;
        const float *w1 = p.in[I_FW1], *b1 = p.in[I_FB1], *w2 = p.in[I_FW2], *b2 = p.in[I_FB2], *wout = p.in[I_FWOUT], *fr = p.in[I_FREQ];
        for (int it = F.bid; it < 144; it += F.G) {
            const bool isc = it >= 128; const int L = isc ? CTX : SEQ; const int l0 = (isc ? it - 128 : it) * 16;
            __syncthreads();
            for (int v = F.tid; v < 1024; v += NTHR) { const int li = v >> 6, j = v & 63, l = l0 + li;
                const float t = (float)l / (float)(L - 1);
                float acc = b1[j] + t * w1[j];
                for (int i = 0; i < 16; ++i) { const float band = 1e-4f + (float)i * ((15.0f - 1e-4f) / 15.0f);
                    const float ph = (6.283185307179586f / (float)L) * (float)l * band;
                    acc += cosf(ph) * w1[(1 + i) * 64 + j] - sinf(ph) * w1[(17 + i) * 64 + j]; }
                h1[v] = sinf(fr[j] * acc); }
            __syncthreads();
            for (int v = F.tid; v < 1024; v += NTHR) { const int li = v >> 6, j = v & 63; float acc = b2[j];
                for (int i = 0; i < 64; ++i) acc += h1[li * 64 + i] * w2[i * 64 + j];
                h2[v] = sinf(fr[j] * acc); }
            __syncthreads();
            float o[16][4];
#pragma unroll
            for (int li = 0; li < 16; ++li) { o[li][0] = 0.f; o[li][1] = 0.f; o[li][2] = 0.f; o[li][3] = 0.f; }
            const int col0 = F.tid * 4;
            for (int i = 0; i < 64; ++i) { const f32x4 w = *(const f32x4*)(wout + (size_t)i * 2048 + col0);
#pragma unroll
                for (int li = 0; li < 16; ++li) { const float h = h2[li * 64 + i]; o[li][0] += h * w.x; o[li][1] += h * w.y; o[li][2] += h * w.z; o[li][3] += h * w.w; } }
            const int dir = col0 >> 10, ord = (col0 >> 9) & 1, c0 = col0 & 511;
            float* tab = isc ? (float*)(ws + WS_KFC) : (float*)(ws + WS_KFL);
#pragma unroll
            for (int cc = 0; cc < 4; ++cc) { const int c = c0 + cc; const float delta = DEC_SLOW + (float)c * ((DEC_FAST - DEC_SLOW) / 511.0f);
                float* trow = tab + (size_t)(ord * 512 + c) * (2 * L);
#pragma unroll
                for (int li = 0; li < 16; ++li) { const int l = l0 + li; const float t = (float)l / (float)(L - 1); const float val = o[li][cc] * __expf(-t * delta);
                    if (dir == 0) trow[L + l] = val; else if (l != 0) trow[L - l] = val; else trow[0] = 0.f; } }
        }
        __syncthreads();
    }
    {
        const int gt = F.bid * NTHR + F.tid;
        if (gt < 2 * 64 * 64) {
            const float lr = fminf(p.in[I_LRE][gt], -1e-4f), li = p.in[I_LIM][gt];
            const float dt = __expf(p.in[I_LSTEP][gt >> 6]);
            const float mag = __expf(lr * dt); const float abr = mag * cosf(li * dt), abi = mag * sinf(li * dt);
            const float den = lr * lr + li * li, nr = abr - 1.f, ni = abi;
            const float cor = (nr * lr + ni * li) / den, coi = (ni * lr - nr * li) / den;
            float* AB = (float*)(ws + WS_S5AB); AB[gt] = abr; AB[8192 + gt] = abi;
            float* BB = (float*)(ws + WS_S5BB);
            for (int k = 0; k < 16; ++k) { const float br = p.in[I_BRE][gt * 16 + k], bi = p.in[I_BIM][gt * 16 + k];
                BB[gt * 16 + k] = cor * br - coi * bi; BB[131072 + gt * 16 + k] = cor * bi + coi * br; }
        }
    }
    {
        LAS TD* td = (LAS TD*)(F.lds + 120 * 1024);
        LAS int* ntot = (LAS int*)(F.lds + 120 * 1024 + 2048);
        if (F.tid == 0) {
            int n = 0, st = 0;
#define ADD_TD(SRC, DST, KK, NN, MODE) do { td[n].src = (SRC); td[n].dst = (bf16_t*)(DST); td[n].K = (KK); td[n].N = (NN); td[n].mode = (MODE); td[n].start = st; st += ((KK) / 64) * ((NN) / 32); ++n; } while (0)
            ADD_TD(p.in[I_EVWIN], ws + WS_W0IN, 1024, 2304, 0);
            ADD_TD(p.in[I_EVWOUT], ws + WS_W0OUT, 1024, 1024, 0);
            ADD_TD(p.in[I_FFG], ws + WS_W0GU, 1024, 2816, 1);
            ADD_TD(p.in[I_FFU], ws + WS_W0GU, 1024, 2816, 2);
            ADD_TD(p.in[I_FFD], ws + WS_W0DN, 2816, 1024, 0);
            ADD_TD(p.in[I_ODWIN], ws + WS_W1IN, 1024, 1024, 0);
            ADD_TD(p.in[I_GLUA], ws + WS_WGLU, 1024, 1024, 1);
            ADD_TD(p.in[I_GLUB], ws + WS_WGLU, 1024, 1024, 2);
            for (int e = 0; e < 8; ++e) {
                ADD_TD(p.in[I_MG] + (size_t)e * 1024 * 3584, ws + WS_WMGU + (size_t)e * 7168 * 1024 * 2, 1024, 3584, 1);
                ADD_TD(p.in[I_MU] + (size_t)e * 1024 * 3584, ws + WS_WMGU + (size_t)e * 7168 * 1024 * 2, 1024, 3584, 2);
                ADD_TD(p.in[I_MD] + (size_t)e * 3584 * 1024, ws + WS_WMDN + (size_t)e * 1024 * 3584 * 2, 3584, 1024, 0);
            }
#undef ADD_TD
            td[n].start = st; ntot[0] = n; ntot[1] = st;
        }
        __syncthreads();
        LAS float* scr = (LAS float*)(F.lds + F.wave * 8448);
        const int nmat = ntot[0], total = ntot[1];
        const int gw = F.bid * NWAVES + F.wave, NGW = F.G * NWAVES;
        int m = 0;
        for (int it = gw; it < total; it += NGW) {
            while (m + 1 < nmat && it >= td[m + 1].start) ++m;
            p0_transpose_item(td[m].src, td[m].K, td[m].N, td[m].dst, td[m].mode, scr, it - td[m].start, F.lane);
        }
    }
}

__device__ __forceinline__ void ld_row(const float* rowp, int lane, f32x4 (&v)[4]) {
    const f32x4* r = (const f32x4*)rowp + lane;
#pragma unroll
    for (int j = 0; j < 4; ++j) v[j] = r[64 * j];
}
__device__ __forceinline__ float row_rinv(const f32x4 (&v)[4]) {
    float s = 0.f;
#pragma unroll
    for (int j = 0; j < 4; ++j) s += (v[j].x * v[j].x + v[j].y * v[j].y) + (v[j].z * v[j].z + v[j].w * v[j].w);
    return rsqrtf(wave_sum(s) * (1.f / D) + EPS);
}
template <int MODE> __device__ __forceinline__ void norm_pass(const Params& p, Frame& F) {
    unsigned char* ws = p.ws;
    const float* MOD = (const float*)(ws + WS_MOD);
    float* X1 = (float*)(ws + WS_X1); const float* R = (const float*)(ws + WS_R); bf16_t* XN = (bf16_t*)(ws + WS_XN);
    const int gw = F.bid * NWAVES + F.wave, NGW = F.G * NWAVES, lane = F.lane;
    const int nrows = (MODE >= 3) ? ML : MT;
    const int lay = (MODE <= 1) ? 0 : 1;
    const float* gpre = (MODE == 0) ? p.in[I_NMPRE] : (MODE == 1) ? p.in[I_NFPRE] : (MODE == 2) ? p.in[I_NMPRE] + D : p.in[I_NFPRE] + D;
    const float* gpost = (MODE == 1) ? p.in[I_NMPOST] : (MODE == 2) ? p.in[I_NFPOST] : (MODE == 3) ? p.in[I_NMPOST] + D : p.in[I_NFPOST] + D;
    const int gate_l = (MODE == 1 || MODE == 2) ? 0 : 1, gate_k = (MODE == 1 || MODE == 3) ? 2 : 5;
    const int sh_k = (MODE == 0 || MODE == 2) ? 0 : 3;
    int* list = (int*)(ws + WS_ROUTE); int* tokpos = list + 8 * 16384; float* tokw = (float*)(tokpos + 2 * 16384);
    unsigned* cnt = (unsigned*)(ws + WS_CTL) + CW_CNT;
    for (int row = gw; row < nrows; row += NGW) {
        const int mr = row < ML ? row / SEQ : 8;
        const float* xin = row < ML ? p.in[I_X] + (size_t)row * D : p.in[I_CTX] + (size_t)(row - ML) * D;
        f32x4 xv[4];
        if (MODE <= 1) ld_row(xin, lane, xv); else ld_row(X1 + (size_t)row * D, lane, xv);
        if (MODE >= 1) {
            f32x4 rv[4];
            if (MODE <= 3) ld_row(R + (size_t)row * D, lane, rv);
            else {
                const bf16_t* Y2 = (const bf16_t*)(ws + WS_Y2);
                const int p0 = tokpos[row * 2], p1 = tokpos[row * 2 + 1]; const float w0 = tokw[row * 2], w1 = tokw[row * 2 + 1];
#pragma unroll
                for (int j = 0; j < 4; ++j) { const u32x2 a = *(const u32x2*)(Y2 + (size_t)p0 * D + 4 * lane + 256 * j), b = *(const u32x2*)(Y2 + (size_t)p1 * D + 4 * lane + 256 * j);
                    rv[j].x = w0 * bf2f(a.x & 0xffffu) + w1 * bf2f(b.x & 0xffffu); rv[j].y = w0 * bf2f(a.x >> 16) + w1 * bf2f(b.x >> 16);
                    rv[j].z = w0 * bf2f(a.y & 0xffffu) + w1 * bf2f(b.y & 0xffffu); rv[j].w = w0 * bf2f(a.y >> 16) + w1 * bf2f(b.y >> 16); }
            }
            const float ri = row_rinv(rv);
            const float* gate = MOD + (size_t)(gate_l * 9 + mr) * 6144 + gate_k * D;
#pragma unroll
            for (int j = 0; j < 4; ++j) { const f32x4 g = *((const f32x4*)gate + lane + 64 * j), gp = *((const f32x4*)gpost + lane + 64 * j);
                xv[j] = xv[j] + g * (rv[j] * ri * gp); }
            if (MODE == 4) {
#pragma unroll
                for (int j = 0; j < 4; ++j) *((f32x4*)(p.out + (size_t)row * D) + lane + 64 * j) = xv[j];
                continue;
            }
#pragma unroll
            for (int j = 0; j < 4; ++j) *((f32x4*)(X1 + (size_t)row * D) + lane + 64 * j) = xv[j];
        }
        const float ri2 = row_rinv(xv);
        const float* sh = MOD + (size_t)(lay * 9 + mr) * 6144 + sh_k * D; const float* sc = sh + D;
        f32x4 hv[4];
#pragma unroll
        for (int j = 0; j < 4; ++j) { const f32x4 g = *((const f32x4*)gpre + lane + 64 * j), s1 = *((const f32x4*)sh + lane + 64 * j), s2 = *((const f32x4*)sc + lane + 64 * j);
            hv[j] = (xv[j] * ri2 * g) * (1.f + s2) + s1;
            u32x2 w; w.x = pk2(hv[j].x, hv[j].y); w.y = pk2(hv[j].z, hv[j].w);
            *(u32x2*)(XN + (size_t)row * D + 4 * lane + 256 * j) = w; }
        if (MODE == 3) {
            float lg[8];
#pragma unroll
            for (int e = 0; e < 8; ++e) lg[e] = 0.f;
            const float* rt = p.in[I_ROUTER];
#pragma unroll
            for (int j = 0; j < 4; ++j) {
                const float hx[4] = {hv[j].x, hv[j].y, hv[j].z, hv[j].w};
#pragma unroll
                for (int q = 0; q < 4; ++q) { const int k = 4 * lane + 256 * j + q; const f32x4 r0 = *(const f32x4*)(rt + k * 8), r1 = *(const f32x4*)(rt + k * 8 + 4);
                    lg[0] += hx[q] * r0.x; lg[1] += hx[q] * r0.y; lg[2] += hx[q] * r0.z; lg[3] += hx[q] * r0.w; lg[4] += hx[q] * r1.x; lg[5] += hx[q] * r1.y; lg[6] += hx[q] * r1.z; lg[7] += hx[q] * r1.w; }
            }
#pragma unroll
            for (int e = 0; e < 8; ++e) lg[e] = wave_sum(lg[e]);
            int e0 = 0; float v0 = lg[0];
#pragma unroll
            for (int e = 1; e < 8; ++e) if (lg[e] > v0) { v0 = lg[e]; e0 = e; }
            int e1 = -1; float v1 = -3.0e38f;
#pragma unroll
            for (int e = 0; e < 8; ++e) if (e != e0 && lg[e] > v1) { v1 = lg[e]; e1 = e; }
            const float w0 = 1.f / (1.f + __expf(v1 - v0)), w1 = 1.f - w0;
            if (lane == 0) {
                const unsigned q0 = __hip_atomic_fetch_add(cnt + e0, 1u, __ATOMIC_RELAXED, __HIP_MEMORY_SCOPE_AGENT);
                const unsigned q1 = __hip_atomic_fetch_add(cnt + e1, 1u, __ATOMIC_RELAXED, __HIP_MEMORY_SCOPE_AGENT);
                list[e0 * 16384 + q0] = row; list[e1 * 16384 + q1] = row;
                tokpos[row * 2] = (e0 << 16) | (int)q0; tokpos[row * 2 + 1] = (e1 << 16) | (int)q1;
                tokw[row * 2] = w0; tokw[row * 2 + 1] = w1;
            }
        }
    }
}

struct Unit { int pm, pn; int e; int nvalid; int orow0; int tix; };
struct DenseSched {
    int nM, nN, G, c;
    __device__ __forceinline__ bool next(int i, Unit& u) const { const int L = i * G + c; if (L >= nM * nN) return false; u.pm = L / nN; u.pn = L % nN; u.e = 0; u.nvalid = 256; u.orow0 = u.pm * 256; u.tix = 0; return true; }
    __device__ __forceinline__ int arow(const Unit& u, int r) const { return u.pm * 256 + r; }
    __device__ __forceinline__ int brow0(const Unit& u) const { return u.pn * 256; }
};
struct MoeSched {
    const LAS int* tab; const int* list; int nN, G, c; bool gather; int bexp;
    __device__ __forceinline__ bool next(int i, Unit& u) const {
        const int L = i * G + c; const int ntile = tab[24]; if (L >= ntile * nN) return false;
        const int rt = L / nN; u.pn = L % nN; int e = 0;
#pragma unroll
        for (int k = 1; k < 8; ++k) if (rt >= tab[16 + k]) e = k;
        const int ti = rt - tab[16 + e]; u.e = e; u.tix = ti; u.pm = rt; u.nvalid = min(256, tab[e] - ti * 256); u.orow0 = tab[8 + e] + ti * 256; return true;
    }
    __device__ __forceinline__ int arow(const Unit& u, int r) const {
        if (gather) { const int q = u.tix * 256 + r; return list[u.e * 16384 + (r < u.nvalid ? q : u.tix * 256)]; }
        return u.orow0 + r;
    }
    __device__ __forceinline__ int brow0(const Unit& u) const { return u.e * bexp + u.pn * 256; }
};
__device__ __forceinline__ void moe_table(const Params& p, Frame& F, LAS int* tab) {
    if (F.tid == 0) {
        const unsigned* cnt = (const unsigned*)(p.ws + WS_CTL) + CW_CNT; int base = 0, tp = 0;
        for (int e = 0; e < 8; ++e) { const int c = (int)__hip_atomic_load(cnt + e, __ATOMIC_RELAXED, __HIP_MEMORY_SCOPE_AGENT); tab[e] = c; tab[8 + e] = base; tab[16 + e] = tp; base += c; tp += (c + 255) / 256; }
        tab[24] = tp;
    }
    __syncthreads();
}

struct EpiBf16 {
    bf16_t* O; int ldc;
    __device__ __forceinline__ void operator()(const f32x4 (&acc)[2][2][4][2], const Unit& u, int wr, int wc, int fr, int fq) const {
#pragma unroll
        for (int ai = 0; ai < 2; ++ai)
#pragma unroll
            for (int m = 0; m < 4; ++m) { const int rl = ai * 128 + wr * 64 + m * 16 + fr; if (rl >= u.nvalid) continue;
                bf16_t* rowp = O + (size_t)(u.orow0 + rl) * ldc + u.pn * 256 + wc * 32 + 8 * fq;
#pragma unroll
                for (int bj = 0; bj < 2; ++bj) { const f32x4 v0 = acc[ai][bj][m][0], v1 = acc[ai][bj][m][1]; u32x4 w; w.x = pk2(v0.x, v0.y); w.y = pk2(v0.z, v0.w); w.z = pk2(v1.x, v1.y); w.w = pk2(v1.z, v1.w);
                    *(u32x4*)(rowp + bj * 128) = w; } }
    }
};
struct EpiF32 {
    float* O; int ldc;
    __device__ __forceinline__ void operator()(const f32x4 (&acc)[2][2][4][2], const Unit& u, int wr, int wc, int fr, int fq) const {
#pragma unroll
        for (int ai = 0; ai < 2; ++ai)
#pragma unroll
            for (int m = 0; m < 4; ++m) { const int rl = ai * 128 + wr * 64 + m * 16 + fr;
                float* rowp = O + (size_t)(u.orow0 + rl) * ldc + u.pn * 256 + wc * 32 + 8 * fq;
#pragma unroll
                for (int bj = 0; bj < 2; ++bj) { *(f32x4*)(rowp + bj * 128) = acc[ai][bj][m][0]; *(f32x4*)(rowp + bj * 128 + 4) = acc[ai][bj][m][1]; } }
    }
};
template <int ACT> struct EpiPair {
    void* O; int ldc;
    __device__ __forceinline__ void operator()(const f32x4 (&acc)[2][2][4][2], const Unit& u, int wr, int wc, int fr, int fq) const {
#pragma unroll
        for (int ai = 0; ai < 2; ++ai)
#pragma unroll
            for (int m = 0; m < 4; ++m) { const int rl = ai * 128 + wr * 64 + m * 16 + fr; if (rl >= u.nvalid) continue;
                const size_t off = (size_t)(u.orow0 + rl) * ldc + u.pn * 128 + wc * 32 + 8 * fq;
                float o[8];
#pragma unroll
                for (int n = 0; n < 2; ++n)
#pragma unroll
                    for (int q = 0; q < 4; ++q) { const float g = acc[ai][0][m][n][q], v = acc[ai][1][m][n][q]; o[n * 4 + q] = (ACT == 0) ? siluf_(g) * v : g * sigmoidf_(v); }
                if (ACT == 0) *(u32x4*)((bf16_t*)O + off) = pack8(o);
                else { *(f32x4*)((float*)O + off) = (f32x4){o[0], o[1], o[2], o[3]}; *(f32x4*)((float*)O + off + 4) = (f32x4){o[4], o[5], o[6], o[7]}; } }
    }
};
struct EpiGroupMajor {
    bf16_t* O;
    __device__ __forceinline__ void operator()(const f32x4 (&acc)[2][2][4][2], const Unit& u, int wr, int wc, int fr, int fq) const {
#pragma unroll
        for (int ai = 0; ai < 2; ++ai)
#pragma unroll
            for (int m = 0; m < 4; ++m) { const int row = u.orow0 + ai * 128 + wr * 64 + m * 16 + fr;
#pragma unroll
                for (int bj = 0; bj < 2; ++bj) { const int col = u.pn * 256 + bj * 128 + wc * 32 + 8 * fq; const f32x4 v0 = acc[ai][bj][m][0], v1 = acc[ai][bj][m][1];
                    u32x4 w; w.x = pk2(v0.x, v0.y); w.y = pk2(v0.z, v0.w); w.z = pk2(v1.x, v1.y); w.w = pk2(v1.z, v1.w);
                    *(u32x4*)(O + ((size_t)(col >> 4) * MT + row) * 16 + (col & 15)) = w; } }
    }
};

template <class Epi, class Sched>
__device__ __forceinline__ void gemm_naive(const bf16_t* A, const bf16_t* Bt, int K, const Sched& S, const Epi& E, Frame& F) {
    const int wr = F.wave >> 2, wc = F.wave & 3, fr = F.lane & 15, fq = F.lane >> 4;
    Unit u;
    for (int i = 0; S.next(i, u); ++i) {
        f32x4 acc[2][2][4][2];
#pragma unroll
        for (int ai = 0; ai < 2; ++ai)
#pragma unroll
            for (int bj = 0; bj < 2; ++bj) {
#pragma unroll
                for (int m = 0; m < 4; ++m) { acc[ai][bj][m][0] = (f32x4){0.f, 0.f, 0.f, 0.f}; acc[ai][bj][m][1] = (f32x4){0.f, 0.f, 0.f, 0.f}; }
                int ao[4], bo[2];
#pragma unroll
                for (int m = 0; m < 4; ++m) ao[m] = S.arow(u, ai * 128 + wr * 64 + m * 16 + fr) * K + 8 * fq;
#pragma unroll
                for (int n = 0; n < 2; ++n) bo[n] = (S.brow0(u) + bj * 128 + wc * 32 + 8 * (fr >> 2) + 4 * n + (fr & 3)) * K + 8 * fq;
#pragma unroll 1
                for (int k0 = 0; k0 < K; k0 += 32) {
                    bf16x8 at[4], bt[2];
#pragma unroll
                    for (int m = 0; m < 4; ++m) at[m] = *(const bf16x8*)(A + (size_t)(unsigned)(ao[m] + k0));
#pragma unroll
                    for (int n = 0; n < 2; ++n) bt[n] = *(const bf16x8*)(Bt + (size_t)(unsigned)(bo[n] + k0));
#pragma unroll
                    for (int m = 0; m < 4; ++m)
#pragma unroll
                        for (int n = 0; n < 2; ++n) acc[ai][bj][m][n] = __builtin_amdgcn_mfma_f32_16x16x32_bf16(bt[n], at[m], acc[ai][bj][m][n], 0, 0, 0);
                }
            }
        E(acc, u, wr, wc, fr, fq);
    }
}

__device__ __forceinline__ void rope8(float* v, int lane, int t) {
    const int q = lane & 7; const bool second = q >= 4; const int q4 = q & 3;
    const float pos = (q4 < 2) ? (float)(t >> 6) : (float)(t & 63);
#pragma unroll
    for (int e = 0; e < 8; ++e) {
        const float other = __shfl_xor(v[e], 4);
        const int fi = (q4 & 1) * 8 + e;
        const float inv = exp2f(-(float)fi * 0.8304820237218405f);
        float sn, cs; sincosf(pos * inv, &sn, &cs);
        v[e] = second ? (other * sn + v[e] * cs) : (v[e] * cs - other * sn);
    }
}
__device__ __forceinline__ void phase_p2(const Params& p, Frame& F) {
    unsigned char* ws = p.ws; const bf16_t* P = (const bf16_t*)(ws + WS_P);
    bf16_t* Qb = (bf16_t*)(ws + WS_QB); bf16_t* Kb = (bf16_t*)(ws + WS_KB); bf16_t* Vb = (bf16_t*)(ws + WS_VB);
    const int gw = F.bid * NWAVES + F.wave, NGW = F.G * NWAVES, lane = F.lane;
    for (int row = gw; row < MT; row += NGW) {
        const bf16_t* prow = P + (size_t)row * INEV;
        const bool lat = row < ML; const int b = lat ? row / SEQ : (row - ML) / CTX; const int t = lat ? row % SEQ : (row - ML) % CTX;
        float v[8];
        unpack8(*(const u32x4*)(prow + 1536 + lane * 8), v);
        float ss = 0.f;
#pragma unroll
        for (int e = 0; e < 8; ++e) ss += v[e] * v[e];
        ss += __shfl_xor(ss, 1); ss += __shfl_xor(ss, 2); ss += __shfl_xor(ss, 4);
        float ri = rsqrtf(ss * (1.f / 64.f) + EPS);
        const int d0 = (lane & 7) * 8;
#pragma unroll
        for (int e = 0; e < 8; ++e) v[e] = v[e] * ri * p.in[I_QN][d0 + e];
        if (lat) rope8(v, lane, t);
#pragma unroll
        for (int e = 0; e < 8; ++e) v[e] *= C2;
        *(u32x4*)(Qb + (size_t)row * 512 + lane * 8) = pack8(v);
        const int l5 = lane & 31;
        unpack8(*(const u32x4*)(prow + 2048 + l5 * 8), v);
        ss = 0.f;
#pragma unroll
        for (int e = 0; e < 8; ++e) ss += v[e] * v[e];
        ss += __shfl_xor(ss, 1); ss += __shfl_xor(ss, 2); ss += __shfl_xor(ss, 4);
        ri = rsqrtf(ss * (1.f / 64.f) + EPS);
        float kv[8];
#pragma unroll
        for (int e = 0; e < 8; ++e) kv[e] = v[e] * ri * p.in[I_KN][d0 + e];
        if (lat) rope8(kv, lane, t);
        const size_t kvrow = (size_t)b * KVL + (lat ? CTX + t : t);
        if (lane < 16) *(u32x4*)(Kb + kvrow * 128 + lane * 8) = pack8(kv);
        else if (lane < 32) *(u32x4*)(Vb + kvrow * 128 + (lane - 16) * 8) = pack8(v);
    }
    {
        LAS float* tile = (LAS float*)(F.lds + F.wave * (64 * 65 * 4));
        bf16_t* ZTL = (bf16_t*)(ws + WS_ZTL); bf16_t* ZTC = (bf16_t*)(ws + WS_ZTC);
        const int nitem = (MT / 64) * 24;
        for (int it = gw; it < nitem; it += NGW) {
            const int rb = it / 24, cb = it % 24, row0 = rb * 64, ch = cb * 64 + lane;
            const bool lat = row0 < ML; const int L = lat ? SEQ : CTX;
            const int b = lat ? row0 / SEQ : (row0 - ML) / CTX; const int t0 = lat ? row0 % SEQ : (row0 - ML) % CTX;
            const float w0 = p.in[I_CONVW][ch], w1 = p.in[I_CONVW][1536 + ch], w2 = p.in[I_CONVW][3072 + ch], cb_ = p.in[I_CONVB][ch];
            const bf16_t* col = P + (size_t)row0 * INEV + ch;
            float prev = (t0 > 0) ? bf2f(col[-(ptrdiff_t)INEV]) : 0.f, cur = bf2f(col[0]);
            for (int r = 0; r < 64; ++r) {
                const float nxt = (t0 + r + 1 < L) ? bf2f(col[(size_t)(r + 1) * INEV]) : 0.f;
                tile[r * 65 + lane] = cb_ + w0 * prev + w1 * cur + w2 * nxt;
                prev = cur; cur = nxt;
            }
            asm volatile("s_waitcnt lgkmcnt(0)" ::: "memory");
            bf16_t* dst = (lat ? ZTL : ZTC) + ((size_t)(cb * 64) * 8 + b) * L + t0 + lane;
            for (int c = 0; c < 64; ++c) dst[(size_t)c * 8 * L] = (bf16_t)f2bf(tile[lane * 65 + c]);
            asm volatile("s_waitcnt lgkmcnt(0)" ::: "memory");
        }
    }
}

__device__ __forceinline__ void attn_naive(const Params& p, Frame& F) {
    unsigned char* ws = p.ws; const bf16_t* Qb = (const bf16_t*)(ws + WS_QB); const bf16_t* Kb = (const bf16_t*)(ws + WS_KB); const bf16_t* Vb = (const bf16_t*)(ws + WS_VB);
    bf16_t* Y = (bf16_t*)(ws + WS_Y);
    const int gw = F.bid * NWAVES + F.wave, NGW = F.G * NWAVES, lane = F.lane;
    for (int it = gw; it < 2304; it += NGW) {
        int b, h, row, nk;
        if (it < 2048) { b = it >> 8; h = (it >> 5) & 7; row = b * SEQ + (it & 31) * 64 + lane; nk = KVL; }
        else { const int j = it - 2048; b = j >> 5; h = (j >> 2) & 7; row = ML + b * CTX + (j & 3) * 64 + lane; nk = CTX; }
        float q[64], o[64];
#pragma unroll
        for (int c = 0; c < 8; ++c) unpack8(*(const u32x4*)(Qb + (size_t)row * 512 + h * 64 + c * 8), q + c * 8);
#pragma unroll
        for (int d = 0; d < 64; ++d) o[d] = 0.f;
        float m = -3.0e38f, l = 0.f;
        const bf16_t* kp = Kb + (size_t)b * KVL * 128 + (h >> 2) * 64; const bf16_t* vp = Vb + (size_t)b * KVL * 128 + (h >> 2) * 64;
        for (int j = 0; j < nk; ++j) {
            float s = 0.f;
#pragma unroll
            for (int c = 0; c < 8; ++c) { float kk[8]; unpack8(*(const u32x4*)(kp + (size_t)j * 128 + c * 8), kk);
#pragma unroll
                for (int e = 0; e < 8; ++e) s += q[c * 8 + e] * kk[e]; }
            const float mn = fmaxf(m, s), al = exp2f(m - mn), pe = exp2f(s - mn);
            l = l * al + pe; m = mn;
#pragma unroll
            for (int c = 0; c < 8; ++c) { float vv[8]; unpack8(*(const u32x4*)(vp + (size_t)j * 128 + c * 8), vv);
#pragma unroll
                for (int e = 0; e < 8; ++e) o[c * 8 + e] = o[c * 8 + e] * al + pe * vv[e]; }
        }
        const float il = 1.f / l;
#pragma unroll
        for (int c = 0; c < 8; ++c) { float t8[8];
#pragma unroll
            for (int e = 0; e < 8; ++e) t8[e] = o[c * 8 + e] * il;
            *(u32x4*)(Y + (size_t)row * D + 512 + h * 64 + c * 8) = pack8(t8); }
    }
}
template <int L> __device__ __forceinline__ void hyena_naive_unit(const Params& p, Frame& F, int c, int b, const bf16_t* ZT, const float* KF, bf16_t* Y, int rowbase) {
    LAS float* sig = (LAS float*)F.lds; LAS float* flt = sig + L;
    constexpr int NT = (L + NTHR - 1) / NTHR;
    __syncthreads();
    for (int t = F.tid; t < L; t += NTHR) sig[t] = bf2f(ZT[((size_t)c * 8 + b) * L + t]);
#pragma unroll 1
    for (int ord = 0; ord < 2; ++ord) {
        for (int i = F.tid; i < 2 * L; i += NTHR) flt[i] = KF[(size_t)(ord * 512 + c) * (2 * L) + i];
        __syncthreads();
        float acc[NT];
#pragma unroll
        for (int q = 0; q < NT; ++q) acc[q] = 0.f;
        for (int s = 0; s < L; ++s) { const float sv = sig[s];
#pragma unroll
            for (int q = 0; q < NT; ++q) { const int t = F.tid + NTHR * q; if (t < L) acc[q] += flt[L + t - s] * sv; } }
        float vn[NT];
#pragma unroll
        for (int q = 0; q < NT; ++q) { const int t = F.tid + NTHR * q; vn[q] = 0.f;
            if (t < L) { const float xg = bf2f(ZT[((size_t)((ord + 1) * 512 + c) * 8 + b) * L + t]); vn[q] = xg * (acc[q] + p.in[I_SKIP][ord * 512 + c] * sig[t]); } }
        __syncthreads();
#pragma unroll
        for (int q = 0; q < NT; ++q) { const int t = F.tid + NTHR * q; if (t < L) sig[t] = vn[q]; }
        __syncthreads();
    }
    for (int t = F.tid; t < L; t += NTHR) Y[(size_t)(rowbase + t) * D + c] = (bf16_t)f2bf(sig[t]);
}
__device__ __forceinline__ void hyena_naive(const Params& p, Frame& F) {
    unsigned char* ws = p.ws; bf16_t* Y = (bf16_t*)(ws + WS_Y);
    for (int it = F.bid; it < 8192; it += F.G) {
        const bool isc = it >= 4096; const int j = isc ? it - 4096 : it; const int c = j >> 3, b = j & 7;
        if (!isc) hyena_naive_unit<SEQ>(p, F, c, b, (const bf16_t*)(ws + WS_ZTL), (const float*)(ws + WS_KFL), Y, b * SEQ);
        else hyena_naive_unit<CTX>(p, F, c, b, (const bf16_t*)(ws + WS_ZTC), (const float*)(ws + WS_KFC), Y, ML + b * CTX);
    }
}

__device__ __forceinline__ void s5_naive(const Params& p, Frame& F) {
    unsigned char* ws = p.ws; const bf16_t* U = (const bf16_t*)(ws + WS_U);
    const float* AB = (const float*)(ws + WS_S5AB); const float* BB = (const float*)(ws + WS_S5BB);
    const int gw = F.bid * NWAVES + F.wave, NGW = F.G * NWAVES, n = F.lane;
    for (int it = gw; it < 1024; it += NGW) {
        const int dir = it >> 9, b = (it >> 6) & 7, g = it & 63; const int gi = (dir * 64 + g) * 64 + n;
        const float ar = AB[gi], ai = AB[8192 + gi];
        float br[16], bi[16], cr[16], ci[16];
#pragma unroll
        for (int k = 0; k < 16; ++k) { br[k] = BB[gi * 16 + k]; bi[k] = BB[131072 + gi * 16 + k];
            cr[k] = p.in[I_CRE][((size_t)(dir * 64 + g) * 16 + k) * 64 + n]; ci[k] = p.in[I_CIM][((size_t)(dir * 64 + g) * 16 + k) * 64 + n]; }
        float* YO = (float*)(ws + (dir == 0 ? WS_YF : WS_YB));
        float sr = 0.f, si = 0.f;
        for (int step = 0; step < KVL; ++step) {
            const bool isc = step < CTX; const int i = isc ? step : step - CTX; const int L = isc ? CTX : SEQ;
            const int t = dir == 0 ? i : L - 1 - i; const int row = isc ? ML + b * CTX + t : b * SEQ + t;
            float u[16]; const bf16_t* up = U + ((size_t)g * MT + row) * 16;
            unpack8(*(const u32x4*)up, u); unpack8(*(const u32x4*)(up + 8), u + 8);
            float bur = 0.f, bui = 0.f;
#pragma unroll
            for (int k = 0; k < 16; ++k) { bur += br[k] * u[k]; bui += bi[k] * u[k]; }
            const float nr = ar * sr - ai * si + bur, ni = ar * si + ai * sr + bui; sr = nr; si = ni;
            if (!isc) {
                float pv[16];
#pragma unroll
                for (int k = 0; k < 16; ++k) pv[k] = cr[k] * sr - ci[k] * si;
                float q8[8], q4[4], q2[2];
#pragma unroll
                for (int k = 0; k < 8; ++k) { const float send = (n & 32) ? pv[k] : pv[k + 8], keep = (n & 32) ? pv[k + 8] : pv[k]; q8[k] = keep + __shfl_xor(send, 32); }
#pragma unroll
                for (int k = 0; k < 4; ++k) { const float send = (n & 16) ? q8[k] : q8[k + 4], keep = (n & 16) ? q8[k + 4] : q8[k]; q4[k] = keep + __shfl_xor(send, 16); }
#pragma unroll
                for (int k = 0; k < 2; ++k) { const float send = (n & 8) ? q4[k] : q4[k + 2], keep = (n & 8) ? q4[k + 2] : q4[k]; q2[k] = keep + __shfl_xor(send, 8); }
                const float send = (n & 4) ? q2[0] : q2[1], keep = (n & 4) ? q2[1] : q2[0];
                float y = keep + __shfl_xor(send, 4);
                y += __shfl_xor(y, 2); y += __shfl_xor(y, 1);
                if ((n & 3) == 0) YO[(size_t)row * D + g * 16 + (n >> 2)] = y;
            }
        }
    }
}
__device__ __forceinline__ void phase_p8b(const Params& p, Frame& F) {
    unsigned char* ws = p.ws; const float* YF = (const float*)(ws + WS_YF); const float* YB = (const float*)(ws + WS_YB); const bf16_t* U = (const bf16_t*)(ws + WS_U); bf16_t* Z = (bf16_t*)(ws + WS_Z);
    const int gt = F.bid * NTHR + F.tid, NGT = F.G * NTHR;
    for (int i = gt; i < ML * (D / 8); i += NGT) {
        const int row = i >> 7, col = (i & 127) * 8;
        const f32x4 a0 = *(const f32x4*)(YF + (size_t)row * D + col), a1 = *(const f32x4*)(YF + (size_t)row * D + col + 4);
        const f32x4 b0 = *(const f32x4*)(YB + (size_t)row * D + col), b1 = *(const f32x4*)(YB + (size_t)row * D + col + 4);
        float u[8]; unpack8(*(const u32x4*)(U + ((size_t)(col >> 4) * MT + row) * 16 + (col & 15)), u);
        const f32x4 d0 = *(const f32x4*)(p.in[I_S5D] + col), d1 = *(const f32x4*)(p.in[I_S5D] + col + 4);
        float o[8];
        o[0] = a0.x + b0.x + d0.x * u[0]; o[1] = a0.y + b0.y + d0.y * u[1]; o[2] = a0.z + b0.z + d0.z * u[2]; o[3] = a0.w + b0.w + d0.w * u[3];
        o[4] = a1.x + b1.x + d1.x * u[4]; o[5] = a1.y + b1.y + d1.y * u[5]; o[6] = a1.z + b1.z + d1.z * u[6]; o[7] = a1.w + b1.w + d1.w * u[7];
#pragma unroll
        for (int e = 0; e < 8; ++e) o[e] = gelu_tanh(o[e]);
        *(u32x4*)(Z + (size_t)row * D + col) = pack8(o);
    }
}
__device__ __forceinline__ void fix_tokpos(const Params& p, Frame& F, const LAS int* tab) {
    int* tokpos = (int*)(p.ws + WS_ROUTE) + 8 * 16384;
    const int gt = F.bid * NTHR + F.tid, NGT = F.G * NTHR;
    for (int i = gt; i < 2 * ML; i += NGT) { const int v = tokpos[i]; tokpos[i] = tab[8 + (v >> 16)] + (v & 0xffff); }
}

constexpr int LDS_BYTES = 147456;
constexpr int NPHASE = 17;
template <int LO, int HI> __global__ void __launch_bounds__(NTHR, 2) mk_fwd(Params p) {
    extern __shared__ __attribute__((aligned(16))) unsigned char lds[];
    Frame F; F.lds = (LAS unsigned char*)lds; F.tid = threadIdx.x; F.lane = F.tid & 63; F.wave = __builtin_amdgcn_readfirstlane(F.tid >> 6); F.G = gridDim.x; F.bid = blockIdx.x;
    unsigned char* ws = p.ws;
#define IN(k) (LO <= (k) && (k) < HI)
    if (IN(0)) phase_p0a(p, F);
    if (IN(1)) norm_pass<0>(p, F);
    if (IN(2)) { DenseSched S{MT / 256, INEV / 256, F.G, F.bid}; EpiBf16 E{(bf16_t*)(ws + WS_P), INEV};
        gemm_naive((const bf16_t*)(ws + WS_XN), (const bf16_t*)(ws + WS_W0IN), D, S, E, F); }
    if (IN(3)) phase_p2(p, F);
    if (IN(4)) { attn_naive(p, F); hyena_naive(p, F); }
    if (IN(5)) { DenseSched S{MT / 256, D / 256, F.G, F.bid}; EpiF32 E{(float*)(ws + WS_R), D};
        gemm_naive((const bf16_t*)(ws + WS_Y), (const bf16_t*)(ws + WS_W0OUT), D, S, E, F); }
    if (IN(6)) norm_pass<1>(p, F);
    if (IN(7)) { DenseSched S{MT / 256, 2 * DFF / 256, F.G, F.bid}; EpiPair<0> E{(void*)(ws + WS_H), DFF};
        gemm_naive((const bf16_t*)(ws + WS_XN), (const bf16_t*)(ws + WS_W0GU), D, S, E, F); }
    if (IN(8)) { DenseSched S{MT / 256, D / 256, F.G, F.bid}; EpiF32 E{(float*)(ws + WS_R), D};
        gemm_naive((const bf16_t*)(ws + WS_H), (const bf16_t*)(ws + WS_W0DN), DFF, S, E, F); }
    if (IN(9)) norm_pass<2>(p, F);
    if (IN(10)) { DenseSched S{MT / 256, D / 256, F.G, F.bid}; EpiGroupMajor E{(bf16_t*)(ws + WS_U)};
        gemm_naive((const bf16_t*)(ws + WS_XN), (const bf16_t*)(ws + WS_W1IN), D, S, E, F); }
    if (IN(11)) s5_naive(p, F);
    if (IN(12)) phase_p8b(p, F);
    if (IN(13)) { DenseSched S{ML / 256, 2 * D / 256, F.G, F.bid}; EpiPair<1> E{(void*)(ws + WS_R), D};
        gemm_naive((const bf16_t*)(ws + WS_Z), (const bf16_t*)(ws + WS_WGLU), D, S, E, F); }
    if (IN(14)) norm_pass<3>(p, F);
    if (IN(15)) { LAS int* tab = (LAS int*)(F.lds + 140 * 1024); moe_table(p, F, tab);
        MoeSched S{tab, (const int*)(ws + WS_ROUTE), 2 * DFE / 256, F.G, F.bid, true, 2 * DFE}; EpiPair<0> E{(void*)(ws + WS_H2), DFE};
        gemm_naive((const bf16_t*)(ws + WS_XN), (const bf16_t*)(ws + WS_WMGU), D, S, E, F); }
    if (IN(16)) { LAS int* tab = (LAS int*)(F.lds + 140 * 1024); moe_table(p, F, tab);
        MoeSched S{tab, (const int*)(ws + WS_ROUTE), D / 256, F.G, F.bid, false, D}; EpiBf16 E{(bf16_t*)(ws + WS_Y2), D};
        gemm_naive((const bf16_t*)(ws + WS_H2), (const bf16_t*)(ws + WS_WMDN), DFE, S, E, F);
        fix_tokpos(p, F, tab); }
    if (IN(17)) norm_pass<4>(p, F);
#undef IN
}

extern "C" void kernel_launch(void* const* d_in, const int* in_sizes, int n_in, void* d_out, int out_size, void* d_ws, size_t ws_size, hipStream_t stream) {
    static int grid = 0;
    if (grid == 0) {
        if (n_in != 41 || out_size != ML * D || ws_size < WS_END) { fprintf(stderr, "kernel_launch: unexpected shapes (n_in %d out %d ws %zu, need %zu)\n", n_in, out_size, ws_size, (size_t)WS_END); grid = -1; return; }
        int dev = 0, cus = 0; (void)hipGetDevice(&dev); (void)hipDeviceGetAttribute(&cus, hipDeviceAttributeMultiprocessorCount, dev);
        grid = cus > 0 ? cus : 256;
    }
    if (grid < 0) return;
    (void)hipMemsetAsync((char*)d_ws + WS_CTL, 0, CTL_ZERO_BYTES, stream);
    Params p{};
    for (int i = 0; i < 41; ++i) p.in[i] = (const float*)d_in[i];
    p.out = (float*)d_out; p.ws = (unsigned char*)d_ws;
#define LAUNCH(PH) do { static bool once##PH = false; if (!once##PH) { (void)hipFuncSetAttribute((const void*)mk_fwd<PH, PH + 1>, hipFuncAttributeMaxDynamicSharedMemorySize, LDS_BYTES); once##PH = true; } \
        hipLaunchKernelGGL((mk_fwd<PH, PH + 1>), dim3(grid), dim3(NTHR), LDS_BYTES, stream, p); } while (0)
    LAUNCH(0); LAUNCH(1); LAUNCH(2); LAUNCH(3); LAUNCH(4); LAUNCH(5); LAUNCH(6); LAUNCH(7); LAUNCH(8); LAUNCH(9); LAUNCH(10); LAUNCH(11); LAUNCH(12); LAUNCH(13); LAUNCH(14); LAUNCH(15); LAUNCH(16); LAUNCH(17);
#undef LAUNCH
}
```

```cpp
#include <hip/hip_runtime.h>
#include <cstdio>
#include <cstdint>
#include <cmath>
#include <hip/hip_bf16.h>

#define LAS __attribute__((address_space(3)))
#define GAS __attribute__((address_space(1)))
typedef unsigned short bf16_t;
typedef short bf16x8 __attribute__((ext_vector_type(8)));
typedef float f32x4 __attribute__((ext_vector_type(4)));
typedef float f32x2 __attribute__((ext_vector_type(2)));
typedef unsigned u32x4 __attribute__((ext_vector_type(4)));
typedef unsigned u32x2 __attribute__((ext_vector_type(2)));

constexpr int D = 1024, NB = 8, SEQ = 2048, CTX = 256;
constexpr int ML = NB * SEQ, MC = NB * CTX, MT = ML + MC;
constexpr int HYW = 512, HYIN = 1536, INEV = 2304, KVL = CTX + SEQ;
constexpr int DFF = 2816, NEXP = 8, DFE = 3584;
constexpr float EPS = 1e-6f;
constexpr float C2 = 0.125f * 1.4426950408889634f;
constexpr float DEC_SLOW = 3.0701134573253945f, DEC_FAST = 15.350567286626973f;
constexpr int NWAVES = 8, NTHR = 512;

constexpr size_t MiB = 1u << 20;
constexpr size_t WS_CTL = 0, CTL_ZERO_BYTES = 1 * MiB;
constexpr size_t WS_MOD = 1 * MiB;
constexpr size_t WS_S5AB = 1 * MiB + 512 * 1024;
constexpr size_t WS_S5BB = 2 * MiB;
constexpr size_t WS_ROUTE = 3 * MiB;
constexpr size_t WS_X1 = 6 * MiB;
constexpr size_t WS_XN = 78 * MiB;
constexpr size_t WS_ZTL = WS_X1;
constexpr size_t WS_ZTC = WS_X1 + 48 * MiB;
constexpr size_t WS_QB = WS_XN;
constexpr size_t WS_KB = WS_XN + 18 * MiB;
constexpr size_t WS_VB = WS_KB + 4 * MiB + 512 * 1024;
constexpr size_t AR = 114 * MiB;
constexpr size_t WS_W0IN = AR + 0;
constexpr size_t WS_W0OUT = AR + 4 * MiB + 512 * 1024;
constexpr size_t WS_W0GU = AR + 6 * MiB + 512 * 1024;
constexpr size_t WS_W0DN = AR + 17 * MiB + 512 * 1024;
constexpr size_t WS_W1IN = AR + 23 * MiB;
constexpr size_t WS_WGLU = AR + 25 * MiB;
constexpr size_t WS_KFL = AR + 29 * MiB;
constexpr size_t WS_KFC = AR + 45 * MiB;
constexpr size_t WS_R = AR + 47 * MiB;
constexpr size_t WS_P = AR + 119 * MiB;
constexpr size_t WS_Y = AR + 119 * MiB;
constexpr size_t WS_H = AR + 119 * MiB;
constexpr size_t WS_U = AR + 119 * MiB;
constexpr size_t WS_YF = AR + 47 * MiB;
constexpr size_t WS_YB = AR + 155 * MiB;
constexpr size_t WS_Z = WS_XN;
constexpr size_t WS_H2 = AR + 0;
constexpr size_t WS_WMGU = AR + 226 * MiB;
constexpr size_t WS_WMDN = AR + 338 * MiB;
constexpr size_t WS_Y2 = AR + 226 * MiB;
constexpr size_t WS_END = AR + 394 * MiB;
constexpr int CW_BAR = 4096;
constexpr int CW_CNT = 256;

struct Params { const float* in[41]; float* out; unsigned char* ws; int ph_lo, ph_hi; };
struct Frame { LAS unsigned char* lds; int tid, lane, wave, G, bid; };

enum { I_X = 0, I_C, I_CTX, I_CCTX, I_ADAW, I_ADAB, I_NMPRE, I_NMPOST, I_NFPRE, I_NFPOST, I_EVWIN, I_CONVW, I_CONVB, I_FW1, I_FB1, I_FW2, I_FB2, I_FWOUT, I_FREQ,
       I_SKIP, I_QN, I_KN, I_EVWOUT, I_FFG, I_FFU, I_FFD, I_ODWIN, I_LRE, I_LIM, I_LSTEP, I_BRE, I_BIM, I_CRE, I_CIM, I_S5D, I_GLUA, I_GLUB, I_ROUTER, I_MG, I_MU, I_MD };

__device__ __forceinline__ float bf2f(unsigned h) { return __uint_as_float(h << 16); }
__device__ __forceinline__ unsigned f2bf(float f) { unsigned u = __float_as_uint(f); return (u + 0x7fffu + ((u >> 16) & 1u)) >> 16; }
__device__ __forceinline__ unsigned pk2(float lo, float hi) { return f2bf(lo) | (f2bf(hi) << 16); }
__device__ __forceinline__ float wave_sum(float v) {
#pragma unroll
    for (int o = 1; o < 64; o <<= 1) v += __shfl_xor(v, o);
    return v;
}
__device__ __forceinline__ float sigmoidf_(float x) { return 1.f / (1.f + __expf(-x)); }
__device__ __forceinline__ float siluf_(float x) { return x / (1.f + __expf(-x)); }
__device__ __forceinline__ float gelu_tanh(float x) { const float u = 0.7978845608028654f * (x + 0.044715f * x * x * x); const float t = 1.f - 2.f / (1.f + __expf(2.f * u)); return 0.5f * x * (1.f + t); }
__device__ __forceinline__ void unpack8(u32x4 r, float* v) {
    v[0] = bf2f(r.x & 0xffffu); v[1] = bf2f(r.x >> 16); v[2] = bf2f(r.y & 0xffffu); v[3] = bf2f(r.y >> 16);
    v[4] = bf2f(r.z & 0xffffu); v[5] = bf2f(r.z >> 16); v[6] = bf2f(r.w & 0xffffu); v[7] = bf2f(r.w >> 16);
}
__device__ __forceinline__ u32x4 pack8(const float* v) { u32x4 r; r.x = pk2(v[0], v[1]); r.y = pk2(v[2], v[3]); r.z = pk2(v[4], v[5]); r.w = pk2(v[6], v[7]); return r; }

struct TD { const float* src; bf16_t* dst; int K, N, mode, start; };
__device__ __forceinline__ void p0_transpose_item(const float* W, int K, int N, bf16_t* WT, int mode, LAS float* scr, int item, int lane) {
    const int nblk = N / 32, kb = item / nblk, nb = item % nblk, k0 = 64 * kb, n0 = 32 * nb;
    const int drow0 = (mode == 0) ? n0 : (256 * (n0 / 128) + (n0 % 128) + (mode == 2 ? 128 : 0));
#pragma unroll 8
    for (int i = 0; i < 32; ++i) { const int kk = 2 * i + (lane >> 5); scr[kk * 33 + (lane & 31)] = W[(size_t)(k0 + kk) * N + n0 + (lane & 31)]; }
    asm volatile("s_waitcnt lgkmcnt(0)" ::: "memory");
    const int c = lane & 7;
#pragma unroll
    for (int j = 0; j < 4; ++j) { const int n = (lane >> 3) + 8 * j; const LAS float* s = scr + (8 * c) * 33 + n;
        u32x4 o; o.x = pk2(s[0 * 33], s[1 * 33]); o.y = pk2(s[2 * 33], s[3 * 33]); o.z = pk2(s[4 * 33], s[5 * 33]); o.w = pk2(s[6 * 33], s[7 * 33]);
        *(u32x4*)(WT + (size_t)(drow0 + n) * K + k0 + 8 * c) = o; }
    asm volatile("s_waitcnt lgkmcnt(0)" ::: "memory");
}

__device__ __forceinline__ void phase_p0a(const Params& p, Frame& F) {
    unsigned char* ws = p.ws;
    {
        LAS float* sc = (LAS float*)F.lds;
        LAS float* red = (LAS float*)(F.lds + 36864);
        const float* c = p.in[I_C]; const float* cc = p.in[I_CCTX];
        for (int i = F.tid; i < 9 * 1024; i += NTHR) { const int r = i >> 10, k = i & 1023; const float v = r < 8 ? c[r * 1024 + k] : cc[k]; sc[i] = siluf_(v); }
        __syncthreads();
        float* MOD = (float*)(ws + WS_MOD);
        for (int it = F.bid; it < 192; it += F.G) {
            const int l = it / 96, n0 = (it % 96) * 64;
            const float* W = p.in[I_ADAW] + (size_t)l * 1024 * 6144 + n0 + F.lane;
            float acc[9];
#pragma unroll
            for (int r = 0; r < 9; ++r) acc[r] = 0.f;
            const int k0 = F.wave * 128;
#pragma unroll 8
            for (int k = 0; k < 128; ++k) { const float w = W[(size_t)(k0 + k) * 6144];
#pragma unroll
                for (int r = 0; r < 9; ++r) acc[r] += sc[r * 1024 + k0 + k] * w; }
#pragma unroll
            for (int r = 0; r < 9; ++r) red[(F.wave * 9 + r) * 64 + F.lane] = acc[r];
            __syncthreads();
            for (int o = F.tid; o < 576; o += NTHR) { const int r = o >> 6, ln = o & 63; float s = p.in[I_ADAB][l * 6144 + n0 + ln];
#pragma unroll
                for (int w = 0; w < 8; ++w) s += red[(w * 9 + r) * 64 + ln];
                MOD[(size_t)(l * 9 + r) * 6144 + n0 + ln] = s; }
            __syncthreads();
        }
    }
    {
        LAS float* h1 = (LAS float*)F.lds; LAS float* h2 = h1 + 1024;
        const float *w1 = p.in[I_FW1], *b1 = p.in[I_FB1], *w2 = p.in[I_FW2], *b2 = p.in[I_FB2], *wout = p.in[I_FWOUT], *fr = p.in[I_FREQ];
        for (int it = F.bid; it < 144; it += F.G) {
            const bool isc = it >= 128; const int L = isc ? CTX : SEQ; const int l0 = (isc ? it - 128 : it) * 16;
            __syncthreads();
            for (int v = F.tid; v < 1024; v += NTHR) { const int li = v >> 6, j = v & 63, l = l0 + li;
                const float t = (float)l / (float)(L - 1);
                float acc = b1[j] + t * w1[j];
                for (int i = 0; i < 16; ++i) { const float band = 1e-4f + (float)i * ((15.0f - 1e-4f) / 15.0f);
                    const float ph = (6.283185307179586f / (float)L) * (float)l * band;
                    acc += cosf(ph) * w1[(1 + i) * 64 + j] - sinf(ph) * w1[(17 + i) * 64 + j]; }
                h1[v] = sinf(fr[j] * acc); }
            __syncthreads();
            for (int v = F.tid; v < 1024; v += NTHR) { const int li = v >> 6, j = v & 63; float acc = b2[j];
                for (int i = 0; i < 64; ++i) acc += h1[li * 64 + i] * w2[i * 64 + j];
                h2[v] = sinf(fr[j] * acc); }
            __syncthreads();
            float o[16][4];
#pragma unroll
            for (int li = 0; li < 16; ++li) { o[li][0] = 0.f; o[li][1] = 0.f; o[li][2] = 0.f; o[li][3] = 0.f; }
            const int col0 = F.tid * 4;
            for (int i = 0; i < 64; ++i) { const f32x4 w = *(const f32x4*)(wout + (size_t)i * 2048 + col0);
#pragma unroll
                for (int li = 0; li < 16; ++li) { const float h = h2[li * 64 + i]; o[li][0] += h * w.x; o[li][1] += h * w.y; o[li][2] += h * w.z; o[li][3] += h * w.w; } }
            const int dir = col0 >> 10, ord = (col0 >> 9) & 1, c0 = col0 & 511;
            float* tab = isc ? (float*)(ws + WS_KFC) : (float*)(ws + WS_KFL);
#pragma unroll
            for (int cc = 0; cc < 4; ++cc) { const int c = c0 + cc; const float delta = DEC_SLOW + (float)c * ((DEC_FAST - DEC_SLOW) / 511.0f);
                float* trow = tab + (size_t)(ord * 512 + c) * (2 * L);
#pragma unroll
                for (int li = 0; li < 16; ++li) { const int l = l0 + li; const float t = (float)l / (float)(L - 1); const float val = o[li][cc] * __expf(-t * delta);
                    if (dir == 0) trow[L + l] = val; else if (l != 0) trow[L - l] = val; else trow[0] = 0.f; } }
        }
        __syncthreads();
    }
    {
        const int gt = F.bid * NTHR + F.tid;
        if (gt < 2 * 64 * 64) {
            const float lr = fminf(p.in[I_LRE][gt], -1e-4f), li = p.in[I_LIM][gt];
            const float dt = __expf(p.in[I_LSTEP][gt >> 6]);
            const float mag = __expf(lr * dt); const float abr = mag * cosf(li * dt), abi = mag * sinf(li * dt);
            const float den = lr * lr + li * li, nr = abr - 1.f, ni = abi;
            const float cor = (nr * lr + ni * li) / den, coi = (ni * lr - nr * li) / den;
            float* AB = (float*)(ws + WS_S5AB); AB[gt] = abr; AB[8192 + gt] = abi;
            float* BB = (float*)(ws + WS_S5BB);
            for (int k = 0; k < 16; ++k) { const float br = p.in[I_BRE][gt * 16 + k], bi = p.in[I_BIM][gt * 16 + k];
                BB[gt * 16 + k] = cor * br - coi * bi; BB[131072 + gt * 16 + k] = cor * bi + coi * br; }
        }
    }
    {
        LAS TD* td = (LAS TD*)(F.lds + 120 * 1024);
        LAS int* ntot = (LAS int*)(F.lds + 120 * 1024 + 2048);
        if (F.tid == 0) {
            int n = 0, st = 0;
#define ADD_TD(SRC, DST, KK, NN, MODE) do { td[n].src = (SRC); td[n].dst = (bf16_t*)(DST); td[n].K = (KK); td[n].N = (NN); td[n].mode = (MODE); td[n].start = st; st += ((KK) / 64) * ((NN) / 32); ++n; } while (0)
            ADD_TD(p.in[I_EVWIN], ws + WS_W0IN, 1024, 2304, 0);
            ADD_TD(p.in[I_EVWOUT], ws + WS_W0OUT, 1024, 1024, 0);
            ADD_TD(p.in[I_FFG], ws + WS_W0GU, 1024, 2816, 1);
            ADD_TD(p.in[I_FFU], ws + WS_W0GU, 1024, 2816, 2);
            ADD_TD(p.in[I_FFD], ws + WS_W0DN, 2816, 1024, 0);
            ADD_TD(p.in[I_ODWIN], ws + WS_W1IN, 1024, 1024, 0);
            ADD_TD(p.in[I_GLUA], ws + WS_WGLU, 1024, 1024, 1);
            ADD_TD(p.in[I_GLUB], ws + WS_WGLU, 1024, 1024, 2);
            for (int e = 0; e < 8; ++e) {
                ADD_TD(p.in[I_MG] + (size_t)e * 1024 * 3584, ws + WS_WMGU + (size_t)e * 7168 * 1024 * 2, 1024, 3584, 1);
                ADD_TD(p.in[I_MU] + (size_t)e * 1024 * 3584, ws + WS_WMGU + (size_t)e * 7168 * 1024 * 2, 1024, 3584, 2);
                ADD_TD(p.in[I_MD] + (size_t)e * 3584 * 1024, ws + WS_WMDN + (size_t)e * 1024 * 3584 * 2, 3584, 1024, 0);
            }
#undef ADD_TD
            td[n].start = st; ntot[0] = n; ntot[1] = st;
        }
        __syncthreads();
        LAS float* scr = (LAS float*)(F.lds + F.wave * 8448);
        const int nmat = ntot[0], total = ntot[1];
        const int gw = F.bid * NWAVES + F.wave, NGW = F.G * NWAVES;
        int m = 0;
        for (int it = gw; it < total; it += NGW) {
            while (m + 1 < nmat && it >= td[m + 1].start) ++m;
            p0_transpose_item(td[m].src, td[m].K, td[m].N, td[m].dst, td[m].mode, scr, it - td[m].start, F.lane);
        }
    }
}

__device__ __forceinline__ void ld_row(const float* rowp, int lane, f32x4 (&v)[4]) {
    const f32x4* r = (const f32x4*)rowp + lane;
#pragma unroll
    for (int j = 0; j < 4; ++j) v[j] = r[64 * j];
}
__device__ __forceinline__ float row_rinv(const f32x4 (&v)[4]) {
    float s = 0.f;
#pragma unroll
    for (int j = 0; j < 4; ++j) s += (v[j].x * v[j].x + v[j].y * v[j].y) + (v[j].z * v[j].z + v[j].w * v[j].w);
    return rsqrtf(wave_sum(s) * (1.f / D) + EPS);
}
template <int MODE> __device__ __forceinline__ void norm_pass(const Params& p, Frame& F) {
    unsigned char* ws = p.ws;
    const float* MOD = (const float*)(ws + WS_MOD);
    float* X1 = (float*)(ws + WS_X1); const float* R = (const float*)(ws + WS_R); bf16_t* XN = (bf16_t*)(ws + WS_XN);
    const int gw = F.bid * NWAVES + F.wave, NGW = F.G * NWAVES, lane = F.lane;
    const int nrows = (MODE >= 3) ? ML : MT;
    const int lay = (MODE <= 1) ? 0 : 1;
    const float* gpre = (MODE == 0) ? p.in[I_NMPRE] : (MODE == 1) ? p.in[I_NFPRE] : (MODE == 2) ? p.in[I_NMPRE] + D : p.in[I_NFPRE] + D;
    const float* gpost = (MODE == 1) ? p.in[I_NMPOST] : (MODE == 2) ? p.in[I_NFPOST] : (MODE == 3) ? p.in[I_NMPOST] + D : p.in[I_NFPOST] + D;
    const int gate_l = (MODE == 1 || MODE == 2) ? 0 : 1, gate_k = (MODE == 1 || MODE == 3) ? 2 : 5;
    const int sh_k = (MODE == 0 || MODE == 2) ? 0 : 3;
    int* list = (int*)(ws + WS_ROUTE); int* tokpos = list + 8 * 16384; float* tokw = (float*)(tokpos + 2 * 16384);
    unsigned* cnt = (unsigned*)(ws + WS_CTL) + CW_CNT;
    for (int row = gw; row < nrows; row += NGW) {
        const int mr = row < ML ? row / SEQ : 8;
        const float* xin = row < ML ? p.in[I_X] + (size_t)row * D : p.in[I_CTX] + (size_t)(row - ML) * D;
        f32x4 xv[4];
        if (MODE <= 1) ld_row(xin, lane, xv); else ld_row(X1 + (size_t)row * D, lane, xv);
        if (MODE >= 1) {
            f32x4 rv[4];
            if (MODE <= 3) ld_row(R + (size_t)row * D, lane, rv);
            else {
                const bf16_t* Y2 = (const bf16_t*)(ws + WS_Y2);
                const int p0 = tokpos[row * 2], p1 = tokpos[row * 2 + 1]; const float w0 = tokw[row * 2], w1 = tokw[row * 2 + 1];
#pragma unroll
                for (int j = 0; j < 4; ++j) { const u32x2 a = *(const u32x2*)(Y2 + (size_t)p0 * D + 4 * lane + 256 * j), b = *(const u32x2*)(Y2 + (size_t)p1 * D + 4 * lane + 256 * j);
                    rv[j].x = w0 * bf2f(a.x & 0xffffu) + w1 * bf2f(b.x & 0xffffu); rv[j].y = w0 * bf2f(a.x >> 16) + w1 * bf2f(b.x >> 16);
                    rv[j].z = w0 * bf2f(a.y & 0xffffu) + w1 * bf2f(b.y & 0xffffu); rv[j].w = w0 * bf2f(a.y >> 16) + w1 * bf2f(b.y >> 16); }
            }
            const float ri = row_rinv(rv);
            const float* gate = MOD + (size_t)(gate_l * 9 + mr) * 6144 + gate_k * D;
#pragma unroll
            for (int j = 0; j < 4; ++j) { const f32x4 g = *((const f32x4*)gate + lane + 64 * j), gp = *((const f32x4*)gpost + lane + 64 * j);
                xv[j] = xv[j] + g * (rv[j] * ri * gp); }
            if (MODE == 4) {
#pragma unroll
                for (int j = 0; j < 4; ++j) *((f32x4*)(p.out + (size_t)row * D) + lane + 64 * j) = xv[j];
                continue;
            }
#pragma unroll
            for (int j = 0; j < 4; ++j) *((f32x4*)(X1 + (size_t)row * D) + lane + 64 * j) = xv[j];
        }
        const float ri2 = row_rinv(xv);
        const float* sh = MOD + (size_t)(lay * 9 + mr) * 6144 + sh_k * D; const float* sc = sh + D;
        f32x4 hv[4];
#pragma unroll
        for (int j = 0; j < 4; ++j) { const f32x4 g = *((const f32x4*)gpre + lane + 64 * j), s1 = *((const f32x4*)sh + lane + 64 * j), s2 = *((const f32x4*)sc + lane + 64 * j);
            hv[j] = (xv[j] * ri2 * g) * (1.f + s2) + s1;
            u32x2 w; w.x = pk2(hv[j].x, hv[j].y); w.y = pk2(hv[j].z, hv[j].w);
            *(u32x2*)(XN + (size_t)row * D + 4 * lane + 256 * j) = w; }
        if (MODE == 3) {
            float lg[8];
#pragma unroll
            for (int e = 0; e < 8; ++e) lg[e] = 0.f;
            const float* rt = p.in[I_ROUTER];
#pragma unroll
            for (int j = 0; j < 4; ++j) {
                const float hx[4] = {hv[j].x, hv[j].y, hv[j].z, hv[j].w};
#pragma unroll
                for (int q = 0; q < 4; ++q) { const int k = 4 * lane + 256 * j + q; const f32x4 r0 = *(const f32x4*)(rt + k * 8), r1 = *(const f32x4*)(rt + k * 8 + 4);
                    lg[0] += hx[q] * r0.x; lg[1] += hx[q] * r0.y; lg[2] += hx[q] * r0.z; lg[3] += hx[q] * r0.w; lg[4] += hx[q] * r1.x; lg[5] += hx[q] * r1.y; lg[6] += hx[q] * r1.z; lg[7] += hx[q] * r1.w; }
            }
#pragma unroll
            for (int e = 0; e < 8; ++e) lg[e] = wave_sum(lg[e]);
            int e0 = 0; float v0 = lg[0];
#pragma unroll
            for (int e = 1; e < 8; ++e) if (lg[e] > v0) { v0 = lg[e]; e0 = e; }
            int e1 = -1; float v1 = -3.0e38f;
#pragma unroll
            for (int e = 0; e < 8; ++e) if (e != e0 && lg[e] > v1) { v1 = lg[e]; e1 = e; }
            const float w0 = 1.f / (1.f + __expf(v1 - v0)), w1 = 1.f - w0;
            if (lane == 0) {
                const unsigned q0 = __hip_atomic_fetch_add(cnt + e0, 1u, __ATOMIC_RELAXED, __HIP_MEMORY_SCOPE_AGENT);
                const unsigned q1 = __hip_atomic_fetch_add(cnt + e1, 1u, __ATOMIC_RELAXED, __HIP_MEMORY_SCOPE_AGENT);
                list[e0 * 16384 + q0] = row; list[e1 * 16384 + q1] = row;
                tokpos[row * 2] = (e0 << 16) | (int)q0; tokpos[row * 2 + 1] = (e1 << 16) | (int)q1;
                tokw[row * 2] = w0; tokw[row * 2 + 1] = w1;
            }
        }
    }
}

struct Unit { int pm, pn; int e; int nvalid; int orow0; int tix; };
struct DenseSched {
    int nM, nN, G, c;
    __device__ __forceinline__ bool next(int i, Unit& u) const { const int L = i * G + c; if (L >= nM * nN) return false; u.pm = L / nN; u.pn = L % nN; u.e = 0; u.nvalid = 256; u.orow0 = u.pm * 256; u.tix = 0; return true; }
    __device__ __forceinline__ int arow(const Unit& u, int r) const { return u.pm * 256 + r; }
    __device__ __forceinline__ int brow0(const Unit& u) const { return u.pn * 256; }
};
struct MoeSched {
    const LAS int* tab; const int* list; int nN, G, c; bool gather; int bexp;
    __device__ __forceinline__ bool next(int i, Unit& u) const {
        const int L = i * G + c; const int ntile = tab[24]; if (L >= ntile * nN) return false;
        const int rt = L / nN; u.pn = L % nN; int e = 0;
#pragma unroll
        for (int k = 1; k < 8; ++k) if (rt >= tab[16 + k]) e = k;
        const int ti = rt - tab[16 + e]; u.e = e; u.tix = ti; u.pm = rt; u.nvalid = min(256, tab[e] - ti * 256); u.orow0 = tab[8 + e] + ti * 256; return true;
    }
    __device__ __forceinline__ int arow(const Unit& u, int r) const {
        if (gather) { const int q = u.tix * 256 + r; return list[u.e * 16384 + (r < u.nvalid ? q : u.tix * 256)]; }
        return u.orow0 + r;
    }
    __device__ __forceinline__ int brow0(const Unit& u) const { return u.e * bexp + u.pn * 256; }
};
__device__ __forceinline__ void moe_table(const Params& p, Frame& F, LAS int* tab) {
    if (F.tid == 0) {
        const unsigned* cnt = (const unsigned*)(p.ws + WS_CTL) + CW_CNT; int base = 0, tp = 0;
        for (int e = 0; e < 8; ++e) { const int c = (int)__hip_atomic_load(cnt + e, __ATOMIC_RELAXED, __HIP_MEMORY_SCOPE_AGENT); tab[e] = c; tab[8 + e] = base; tab[16 + e] = tp; base += c; tp += (c + 255) / 256; }
        tab[24] = tp;
    }
    __syncthreads();
}

struct EpiBf16 {
    bf16_t* O; int ldc;
    __device__ __forceinline__ void operator()(const f32x4 (&acc)[2][2][4][2], const Unit& u, int wr, int wc, int fr, int fq) const {
#pragma unroll
        for (int ai = 0; ai < 2; ++ai)
#pragma unroll
            for (int m = 0; m < 4; ++m) { const int rl = ai * 128 + wr * 64 + m * 16 + fr; if (rl >= u.nvalid) continue;
                bf16_t* rowp = O + (size_t)(u.orow0 + rl) * ldc + u.pn * 256 + wc * 32 + 8 * fq;
#pragma unroll
                for (int bj = 0; bj < 2; ++bj) { const f32x4 v0 = acc[ai][bj][m][0], v1 = acc[ai][bj][m][1]; u32x4 w; w.x = pk2(v0.x, v0.y); w.y = pk2(v0.z, v0.w); w.z = pk2(v1.x, v1.y); w.w = pk2(v1.z, v1.w);
                    *(u32x4*)(rowp + bj * 128) = w; } }
    }
};
struct EpiF32 {
    float* O; int ldc;
    __device__ __forceinline__ void operator()(const f32x4 (&acc)[2][2][4][2], const Unit& u, int wr, int wc, int fr, int fq) const {
#pragma unroll
        for (int ai = 0; ai < 2; ++ai)
#pragma unroll
            for (int m = 0; m < 4; ++m) { const int rl = ai * 128 + wr * 64 + m * 16 + fr;
                float* rowp = O + (size_t)(u.orow0 + rl) * ldc + u.pn * 256 + wc * 32 + 8 * fq;
#pragma unroll
                for (int bj = 0; bj < 2; ++bj) { *(f32x4*)(rowp + bj * 128) = acc[ai][bj][m][0]; *(f32x4*)(rowp + bj * 128 + 4) = acc[ai][bj][m][1]; } }
    }
};
template <int ACT> struct EpiPair {
    void* O; int ldc;
    __device__ __forceinline__ void operator()(const f32x4 (&acc)[2][2][4][2], const Unit& u, int wr, int wc, int fr, int fq) const {
#pragma unroll
        for (int ai = 0; ai < 2; ++ai)
#pragma unroll
            for (int m = 0; m < 4; ++m) { const int rl = ai * 128 + wr * 64 + m * 16 + fr; if (rl >= u.nvalid) continue;
                const size_t off = (size_t)(u.orow0 + rl) * ldc + u.pn * 128 + wc * 32 + 8 * fq;
                float o[8];
#pragma unroll
                for (int n = 0; n < 2; ++n)
#pragma unroll
                    for (int q = 0; q < 4; ++q) { const float g = acc[ai][0][m][n][q], v = acc[ai][1][m][n][q]; o[n * 4 + q] = (ACT == 0) ? siluf_(g) * v : g * sigmoidf_(v); }
                if (ACT == 0) *(u32x4*)((bf16_t*)O + off) = pack8(o);
                else { *(f32x4*)((float*)O + off) = (f32x4){o[0], o[1], o[2], o[3]}; *(f32x4*)((float*)O + off + 4) = (f32x4){o[4], o[5], o[6], o[7]}; } }
    }
};
struct EpiGroupMajor {
    bf16_t* O;
    __device__ __forceinline__ void operator()(const f32x4 (&acc)[2][2][4][2], const Unit& u, int wr, int wc, int fr, int fq) const {
#pragma unroll
        for (int ai = 0; ai < 2; ++ai)
#pragma unroll
            for (int m = 0; m < 4; ++m) { const int row = u.orow0 + ai * 128 + wr * 64 + m * 16 + fr;
#pragma unroll
                for (int bj = 0; bj < 2; ++bj) { const int col = u.pn * 256 + bj * 128 + wc * 32 + 8 * fq; const f32x4 v0 = acc[ai][bj][m][0], v1 = acc[ai][bj][m][1];
                    u32x4 w; w.x = pk2(v0.x, v0.y); w.y = pk2(v0.z, v0.w); w.z = pk2(v1.x, v1.y); w.w = pk2(v1.z, v1.w);
                    *(u32x4*)(O + ((size_t)(col >> 4) * MT + row) * 16 + (col & 15)) = w; } }
    }
};

namespace pg8 {
constexpr int BK = 64, HALF = 128, HTB = HALF * BK * 2, STAGE_BYTES = 8 * HTB;
__device__ __forceinline__ int lds_byte(int r, int c) { const int st = (r >> 4) * 2 + (c >> 5), rr = r & 15, cc = c & 31, ob = rr * 64 + cc * 2; return st * 1024 + (ob ^ (((ob >> 9) & 1) << 5)); }
__device__ __forceinline__ void stage_rc(int b, int& R, int& C) { const int st = b / 1024, sb = b % 1024, swz = sb ^ (((sb >> 9) & 1) << 5); R = (st >> 1) * 16 + swz / 64; C = (st & 1) * 32 + (swz % 64) / 2; }
__device__ __forceinline__ int perm32(int rho) { const int n = rho >> 4, i = rho & 15; return 8 * (i >> 2) + 4 * n + (i & 3); }

template <class Epi, class Sched>
__device__ __forceinline__ void gemm_phase(LAS unsigned char* lds, const bf16_t* Ag, const bf16_t* Bg, const int K, const Sched& S, const Epi& E) {
    const int tid = threadIdx.x, wid = __builtin_amdgcn_readfirstlane(tid >> 6), lane = tid & 63, wr = wid >> 2, wc = wid & 3, fr = lane & 15, fq = lane >> 4;
    const int nt = K / BK;
    int sR[2], sC[2]; unsigned voffB[2];
#pragma unroll
    for (int i = 0; i < 2; ++i) { int R, C; stage_rc(tid * 16 + i * 8192, R, C); sR[i] = R; sC[i] = C; const int Rb = (R & ~31) + perm32(R & 31); voffB[i] = (unsigned)(Rb * K + C) * 2u; }
    const unsigned kstep = (unsigned)(BK * 2);
    const size_t hstepB = (size_t)HALF * K * 2;
    const unsigned ldsw = (unsigned)wid * 1024u;
    const int aoff = lds_byte(wr * 64 + fr, fq * 8), boff = lds_byte(wc * 32 + fr, fq * 8);
    const char* Ab = (const char*)Ag;
#define PG8_SA(b, h) (((b) * 2 + (h)) * HTB)
#define PG8_SB(b, h) ((4 + (b) * 2 + (h)) * HTB)
#define PG8_STAGE_B(bufoff, gbase) do { _Pragma("unroll") for (int _i = 0; _i < 2; ++_i) \
        __builtin_amdgcn_global_load_lds((const unsigned*)((const char*)(gbase) + voffB[_i]), (LAS unsigned*)(lds + (bufoff) + ldsw + _i * 8192), 16, 0, 0); } while (0)
#define PG8_STAGE_A(bufoff, vo, kb) do { _Pragma("unroll") for (int _i = 0; _i < 2; ++_i) \
        __builtin_amdgcn_global_load_lds((const unsigned*)(Ab + (size_t)((vo)[_i] + (kb))), (LAS unsigned*)(lds + (bufoff) + ldsw + _i * 8192), 16, 0, 0); } while (0)
#define PG8_LDA(dst, b, h) do { _Pragma("unroll") for (int m = 0; m < 4; ++m) _Pragma("unroll") for (int k = 0; k < 2; ++k) dst[m][k] = *(const LAS bf16x8*)(lds + PG8_SA(b, h) + aoff + m * 2048 + k * 1024); } while (0)
#define PG8_LDB(dst, b, h) do { _Pragma("unroll") for (int n = 0; n < 2; ++n) _Pragma("unroll") for (int k = 0; k < 2; ++k) dst[n][k] = *(const LAS bf16x8*)(lds + PG8_SB(b, h) + boff + n * 2048 + k * 1024); } while (0)
#define PG8_MMA(ai, bj, At, Bt) do { __builtin_amdgcn_s_setprio(1); _Pragma("unroll") for (int m = 0; m < 4; ++m) _Pragma("unroll") for (int n = 0; n < 2; ++n) _Pragma("unroll") for (int k = 0; k < 2; ++k) \
        acc[ai][bj][m][n] = __builtin_amdgcn_mfma_f32_16x16x32_bf16(Bt[n][k], At[m][k], acc[ai][bj][m][n], 0, 0, 0); __builtin_amdgcn_s_setprio(0); } while (0)
#define PG8_WAIT_V(n) asm volatile("s_waitcnt vmcnt(" #n ")" ::: "memory")
#define PG8_WAIT_L(n) asm volatile("s_waitcnt lgkmcnt(" #n ")" ::: "memory")
#define PG8_BAR __builtin_amdgcn_s_barrier()
#define PG8_SCHED __builtin_amdgcn_sched_barrier(0)
#define PG8_UNIT_OFFS(u, vo) do { _Pragma("unroll") for (int _h = 0; _h < 2; ++_h) _Pragma("unroll") for (int _i = 0; _i < 2; ++_i) (vo)[_h][_i] = (unsigned)(S.arow((u), _h * HALF + sR[_i]) * K + sC[_i]) * 2u; } while (0)
    Unit cur, nxt; int ui = 0;
    if (!S.next(0, cur)) return;
    f32x4 acc[2][2][4][2];
#pragma unroll
    for (int a = 0; a < 2; ++a)
#pragma unroll
        for (int b = 0; b < 2; ++b)
#pragma unroll
            for (int m = 0; m < 4; ++m)
#pragma unroll
                for (int n = 0; n < 2; ++n) acc[a][b][m][n] = (f32x4){0.f, 0.f, 0.f, 0.f};
    bf16x8 At[4][2], B0[2][2], B1[2][2];
    unsigned vc[2][2], vn[2][2];
    PG8_UNIT_OFFS(cur, vc);
    asm volatile("" : "+v"(vc[0][0]), "+v"(vc[0][1]), "+v"(vc[1][0]), "+v"(vc[1][1]));
    const char* cB = (const char*)Bg + (size_t)S.brow0(cur) * K * 2;
    PG8_STAGE_B(PG8_SB(0, 0), cB); PG8_STAGE_B(PG8_SB(0, 1), cB + hstepB); PG8_STAGE_A(PG8_SA(0, 0), vc[0], 0u); PG8_STAGE_A(PG8_SA(0, 1), vc[1], 0u);
    if (wr == 1) PG8_BAR;
    PG8_WAIT_V(2); PG8_BAR;
    PG8_STAGE_B(PG8_SB(1, 0), cB + kstep); PG8_STAGE_A(PG8_SA(1, 0), vc[0], kstep); PG8_STAGE_B(PG8_SB(1, 1), cB + hstepB + kstep);
    PG8_WAIT_V(6); PG8_BAR;
    for (;;) {
        const bool has_next = S.next(ui + 1, nxt);
        if (has_next) { PG8_UNIT_OFFS(nxt, vn); } else {
#pragma unroll
            for (int h = 0; h < 2; ++h) { vn[h][0] = vc[h][0]; vn[h][1] = vc[h][1]; } }
        asm volatile("" : "+v"(vn[0][0]), "+v"(vn[0][1]), "+v"(vn[1][0]), "+v"(vn[1][1]));
        const char* nB = has_next ? (const char*)Bg + (size_t)S.brow0(nxt) * K * 2 : cB;
        for (int t = 0; t < nt; t += 2) {
            const bool last = (t == nt - 2);
            const unsigned ka1 = (unsigned)(t + 1) * kstep, ka2 = last ? 0u : (unsigned)(t + 2) * kstep;
            unsigned o2[2][2];
#pragma unroll
            for (int h = 0; h < 2; ++h) { o2[h][0] = (last ? vn[h][0] : vc[h][0]) + ka2; o2[h][1] = (last ? vn[h][1] : vc[h][1]) + ka2; }
            const char* b2 = last ? nB : cB + (size_t)(t + 2) * kstep; const char* b3 = b2 + kstep;
            PG8_LDB(B0, 0, 0); PG8_LDB(B1, 0, 1); PG8_SCHED; PG8_LDA(At, 0, 0); PG8_STAGE_A(PG8_SA(1, 1), vc[1], ka1);
            PG8_WAIT_V(8); PG8_WAIT_L(0); PG8_BAR; PG8_MMA(0, 0, At, B0); PG8_MMA(0, 1, At, B1); PG8_BAR; PG8_SCHED;
            PG8_LDA(At, 0, 1); PG8_STAGE_B(PG8_SB(0, 0), b2); PG8_STAGE_B(PG8_SB(0, 1), b2 + hstepB); PG8_STAGE_A(PG8_SA(0, 0), o2[0], 0u);
            PG8_WAIT_V(8); PG8_WAIT_L(0); PG8_BAR; PG8_MMA(1, 0, At, B0); PG8_MMA(1, 1, At, B1); PG8_BAR; PG8_SCHED;
            PG8_LDB(B0, 1, 0); PG8_LDB(B1, 1, 1); PG8_SCHED; PG8_LDA(At, 1, 0); PG8_STAGE_A(PG8_SA(0, 1), o2[1], 0u);
            PG8_WAIT_V(8); PG8_WAIT_L(0); PG8_BAR; PG8_MMA(0, 0, At, B0); PG8_MMA(0, 1, At, B1); PG8_BAR; PG8_SCHED;
            PG8_LDA(At, 1, 1); PG8_STAGE_B(PG8_SB(1, 0), b3); PG8_STAGE_B(PG8_SB(1, 1), b3 + hstepB); PG8_STAGE_A(PG8_SA(1, 0), o2[0], kstep);
            PG8_WAIT_V(8); PG8_WAIT_L(0); PG8_BAR; PG8_MMA(1, 0, At, B0); PG8_MMA(1, 1, At, B1); PG8_BAR; PG8_SCHED;
        }
        if (wr == 0) PG8_BAR;
        E(acc, cur, wr, wc, fr, fq);
        if (!has_next) break;
#pragma unroll
        for (int a = 0; a < 2; ++a)
#pragma unroll
            for (int b = 0; b < 2; ++b)
#pragma unroll
                for (int m = 0; m < 4; ++m)
#pragma unroll
                    for (int n = 0; n < 2; ++n) acc[a][b][m][n] = (f32x4){0.f, 0.f, 0.f, 0.f};
        cur = nxt; cB = nB; ++ui;
#pragma unroll
        for (int h = 0; h < 2; ++h) { vc[h][0] = vn[h][0]; vc[h][1] = vn[h][1]; }
        if (wr == 1) PG8_BAR;
    }
    PG8_WAIT_V(0);
    PG8_BAR;
#undef PG8_SA
#undef PG8_SB
#undef PG8_STAGE_A
#undef PG8_STAGE_B
#undef PG8_LDA
#undef PG8_LDB
#undef PG8_MMA
#undef PG8_WAIT_V
#undef PG8_WAIT_L
#undef PG8_BAR
#undef PG8_SCHED
#undef PG8_UNIT_OFFS
}
}

__device__ __forceinline__ void rope8(float* v, int lane, int t) {
    const int q = lane & 7; const bool second = q >= 4; const int q4 = q & 3;
    const float pos = (q4 < 2) ? (float)(t >> 6) : (float)(t & 63);
#pragma unroll
    for (int e = 0; e < 8; ++e) {
        const float other = __shfl_xor(v[e], 4);
        const int fi = (q4 & 1) * 8 + e;
        const float inv = exp2f(-(float)fi * 0.8304820237218405f);
        float sn, cs; sincosf(pos * inv, &sn, &cs);
        v[e] = second ? (other * sn + v[e] * cs) : (v[e] * cs - other * sn);
    }
}
__device__ __forceinline__ void phase_p2(const Params& p, Frame& F) {
    unsigned char* ws = p.ws; const bf16_t* P = (const bf16_t*)(ws + WS_P);
    bf16_t* Qb = (bf16_t*)(ws + WS_QB); bf16_t* Kb = (bf16_t*)(ws + WS_KB); bf16_t* Vb = (bf16_t*)(ws + WS_VB);
    const int gw = F.bid * NWAVES + F.wave, NGW = F.G * NWAVES, lane = F.lane;
    for (int row = gw; row < MT; row += NGW) {
        const bf16_t* prow = P + (size_t)row * INEV;
        const bool lat = row < ML; const int b = lat ? row / SEQ : (row - ML) / CTX; const int t = lat ? row % SEQ : (row - ML) % CTX;
        float v[8];
        unpack8(*(const u32x4*)(prow + 1536 + lane * 8), v);
        float ss = 0.f;
#pragma unroll
        for (int e = 0; e < 8; ++e) ss += v[e] * v[e];
        ss += __shfl_xor(ss, 1); ss += __shfl_xor(ss, 2); ss += __shfl_xor(ss, 4);
        float ri = rsqrtf(ss * (1.f / 64.f) + EPS);
        const int d0 = (lane & 7) * 8;
#pragma unroll
        for (int e = 0; e < 8; ++e) v[e] = v[e] * ri * p.in[I_QN][d0 + e];
        if (lat) rope8(v, lane, t);
#pragma unroll
        for (int e = 0; e < 8; ++e) v[e] *= C2;
        *(u32x4*)(Qb + (size_t)row * 512 + lane * 8) = pack8(v);
        const int l5 = lane & 31;
        unpack8(*(const u32x4*)(prow + 2048 + l5 * 8), v);
        ss = 0.f;
#pragma unroll
        for (int e = 0; e < 8; ++e) ss += v[e] * v[e];
        ss += __shfl_xor(ss, 1); ss += __shfl_xor(ss, 2); ss += __shfl_xor(ss, 4);
        ri = rsqrtf(ss * (1.f / 64.f) + EPS);
        float kv[8];
#pragma unroll
        for (int e = 0; e < 8; ++e) kv[e] = v[e] * ri * p.in[I_KN][d0 + e];
        if (lat) rope8(kv, lane, t);
        const size_t kvrow = (size_t)b * KVL + (lat ? CTX + t : t);
        if (lane < 16) *(u32x4*)(Kb + kvrow * 128 + lane * 8) = pack8(kv);
        else if (lane < 32) *(u32x4*)(Vb + kvrow * 128 + (lane - 16) * 8) = pack8(v);
    }
    {
        LAS float* tile = (LAS float*)(F.lds + F.wave * (64 * 65 * 4));
        bf16_t* ZTL = (bf16_t*)(ws + WS_ZTL); bf16_t* ZTC = (bf16_t*)(ws + WS_ZTC);
        const int nitem = (MT / 64) * 24;
        for (int it = gw; it < nitem; it += NGW) {
            const int rb = it / 24, cb = it % 24, row0 = rb * 64, ch = cb * 64 + lane;
            const bool lat = row0 < ML; const int L = lat ? SEQ : CTX;
            const int b = lat ? row0 / SEQ : (row0 - ML) / CTX; const int t0 = lat ? row0 % SEQ : (row0 - ML) % CTX;
            const float w0 = p.in[I_CONVW][ch], w1 = p.in[I_CONVW][1536 + ch], w2 = p.in[I_CONVW][3072 + ch], cb_ = p.in[I_CONVB][ch];
            const bf16_t* col = P + (size_t)row0 * INEV + ch;
            float prev = (t0 > 0) ? bf2f(col[-(ptrdiff_t)INEV]) : 0.f, cur = bf2f(col[0]);
            for (int r = 0; r < 64; ++r) {
                const float nxt = (t0 + r + 1 < L) ? bf2f(col[(size_t)(r + 1) * INEV]) : 0.f;
                tile[r * 65 + lane] = cb_ + w0 * prev + w1 * cur + w2 * nxt;
                prev = cur; cur = nxt;
            }
            asm volatile("s_waitcnt lgkmcnt(0)" ::: "memory");
            bf16_t* dst = (lat ? ZTL : ZTC) + ((size_t)(cb * 64) * 8 + b) * L + t0 + lane;
            for (int c = 0; c < 64; ++c) dst[(size_t)c * 8 * L] = (bf16_t)f2bf(tile[lane * 65 + c]);
            asm volatile("s_waitcnt lgkmcnt(0)" ::: "memory");
        }
    }
}

namespace attn_body {
using bf16=__hip_bfloat16;
using bf16x8=__attribute__((ext_vector_type(8)))short;
using s16x4=__attribute__((ext_vector_type(4)))short;
using f32x16=__attribute__((ext_vector_type(16)))float;
using u32x4=__attribute__((ext_vector_type(4)))unsigned;
constexpr int D=64,QP=512,KP=128,OP=1024;
constexpr int NW=8,QBLK=32,QB=QBLK*NW,KVBLK=64;
constexpr int ATTN_UNIT_ROWS=QB;
__device__ __forceinline__ int crow(int r,int hi){return (r&3)+8*(r>>2)+4*hi;}
#define SBAR() __builtin_amdgcn_sched_barrier(0)
__device__ __forceinline__ void cmask(f32x16&p0,f32x16&p1,int jb,int qrel,int hi){
  const float NEG=-INFINITY; int kb=64*jb+4*hi;
  #pragma unroll
  for(int r=0;r<16;++r){int kv=kb+(r&3)+8*(r>>2); if(kv>qrel)p0[r]=NEG; if(kv+32>qrel)p1[r]=NEG;}
}

constexpr int NSLOT=3, SLOTB=8192;
constexpr int LDS_K=0, LDS_V=NSLOT*SLOTB, LDS_WS=2*NSLOT*SLOTB, LDS_OST=LDS_WS+NW*64*4, LDS_BYTES=LDS_OST+NW*4096;
constexpr float C2=0.125f*1.4426950408889634f;
__device__ __forceinline__ void glds16(const void*gsrc,unsigned lds_dst){unsigned keep;
  asm volatile("s_mov_b32 %0, m0\n\ts_mov_b32 m0, %2\n\ts_nop 0\n\tglobal_load_lds_dwordx4 %1, off\n\ts_mov_b32 m0, %0":"=&s"(keep):"v"(gsrc),"s"(lds_dst):"memory");}
__device__ __forceinline__ float max3f(float a,float b,float c){float r;asm("v_max3_f32 %0, %1, %2, %3":"=v"(r):"v"(a),"v"(b),"v"(c));return r;}
__device__ __forceinline__ float max2f(float a,float b){float r;asm("v_max_f32_e32 %0, %1, %2":"=v"(r):"v"(a),"v"(b));return r;}
__device__ __forceinline__ float fadd_s(float a,float b){float r;asm("v_add_f32_e32 %0, %1, %2":"=v"(r):"v"(a),"v"(b));return r;}
__device__ __forceinline__ float fsub_s(float a,float b){float r;asm("v_sub_f32_e32 %0, %1, %2":"=v"(r):"v"(a),"v"(b));return r;}
typedef float f32x2_t __attribute__((ext_vector_type(2))); typedef __bf16 bf16x2_t __attribute__((ext_vector_type(2)));
__device__ __forceinline__ unsigned cvtpk_s(float lo,float hi){f32x2_t v={lo,hi};bf16x2_t b=__builtin_convertvector(v,bf16x2_t);return __builtin_bit_cast(unsigned,b);}
#define WAIT_BAR(N) asm volatile("s_waitcnt vmcnt(" #N ") lgkmcnt(0)\n\ts_barrier":::"memory")

__device__ __forceinline__ void qkt(f32x16&p0,f32x16&p1,const char*Kslot,const bf16x8*qr,const f32x16&negm,int r32,int hi){
  const char*kb=Kslot+hi*1024+r32*16;
  #pragma unroll
  for(int d0=0;d0<4;++d0){
    const bf16x8 b0=*reinterpret_cast<const bf16x8*>(kb+d0*2048);
    const bf16x8 b1=*reinterpret_cast<const bf16x8*>(kb+d0*2048+512);
    if(d0==0){p0=__builtin_amdgcn_mfma_f32_32x32x16_bf16(b0,qr[0],negm,0,0,0);p1=__builtin_amdgcn_mfma_f32_32x32x16_bf16(b1,qr[0],negm,0,0,0);}
    else{p0=__builtin_amdgcn_mfma_f32_32x32x16_bf16(b0,qr[d0],p0,0,0,0);p1=__builtin_amdgcn_mfma_f32_32x32x16_bf16(b1,qr[d0],p1,0,0,0);}}
}
typedef __attribute__((address_space(3))) const char* lds_cptr;
typedef short v4i16_t __attribute__((ext_vector_type(4)));
__device__ __forceinline__ void kload8(bf16x8*kf,lds_cptr kp){
  kf[0]=*(const __attribute__((address_space(3))) bf16x8*)(kp);      kf[1]=*(const __attribute__((address_space(3))) bf16x8*)(kp+512);
  kf[2]=*(const __attribute__((address_space(3))) bf16x8*)(kp+2048); kf[3]=*(const __attribute__((address_space(3))) bf16x8*)(kp+2560);
  kf[4]=*(const __attribute__((address_space(3))) bf16x8*)(kp+4096); kf[5]=*(const __attribute__((address_space(3))) bf16x8*)(kp+4608);
  kf[6]=*(const __attribute__((address_space(3))) bf16x8*)(kp+6144); kf[7]=*(const __attribute__((address_space(3))) bf16x8*)(kp+6656);
}
__device__ __forceinline__ void kload2(bf16x8*kf,lds_cptr kp,int j){ kf[2*j]=*(const __attribute__((address_space(3))) bf16x8*)(kp+j*2048); kf[2*j+1]=*(const __attribute__((address_space(3))) bf16x8*)(kp+j*2048+512); }
__device__ __forceinline__ s16x4 vtr(lds_cptr p){ return __builtin_bit_cast(s16x4,__builtin_amdgcn_ds_read_tr16_b64_v4i16((__attribute__((address_space(3))) v4i16_t*)p)); }
__device__ __forceinline__ float rowmax(const f32x16&p0,const f32x16&p1){
  float a=max3f(p0[0],p0[1],p1[0]),b=max3f(p0[2],p0[3],p1[1]);a=max3f(a,p1[2],p1[3]);
  #pragma unroll
  for(int r=4;r<16;r+=4){a=max3f(a,p0[r],p0[r+1]);b=max3f(b,p0[r+2],p0[r+3]);a=max3f(a,p1[r],p1[r+1]);b=max3f(b,p1[r+2],p1[r+3]);}
  const float m=max2f(a,b);
  auto rr=__builtin_amdgcn_permlane32_swap(__float_as_uint(m),__float_as_uint(m),false,false);
  return max2f(__uint_as_float(rr[0]),__uint_as_float(rr[1]));
}
__device__ __forceinline__ void pv(f32x16*o,int vb,bf16x8 pa0,bf16x8 pa1,bf16x8 pa2,bf16x8 pa3){
  #pragma unroll
  for(int d0=0;d0<2;++d0){s16x4 lo[4],hi[4];
    #pragma unroll
    for(int ks=0;ks<4;++ks){
      asm volatile("ds_read_b64_tr_b16 %0,%1 offset:%c2":"=&v"(lo[ks]):"v"(vb),"i"(d0*4096+ks*1024):"memory");
      asm volatile("ds_read_b64_tr_b16 %0,%1 offset:%c2":"=&v"(hi[ks]):"v"(vb),"i"(d0*4096+ks*1024+512):"memory");}
    asm volatile("s_waitcnt lgkmcnt(0)":::"memory");SBAR();
    #define PK(k) (bf16x8){lo[k][0],lo[k][1],lo[k][2],lo[k][3],hi[k][0],hi[k][1],hi[k][2],hi[k][3]}
    o[d0]=__builtin_amdgcn_mfma_f32_32x32x16_bf16(pa0,PK(0),o[d0],0,0,0);
    o[d0]=__builtin_amdgcn_mfma_f32_32x32x16_bf16(pa1,PK(1),o[d0],0,0,0);
    o[d0]=__builtin_amdgcn_mfma_f32_32x32x16_bf16(pa2,PK(2),o[d0],0,0,0);
    o[d0]=__builtin_amdgcn_mfma_f32_32x32x16_bf16(pa3,PK(3),o[d0],0,0,0);
    #undef PK
  }
}

#ifndef ATTN_STORE16
#define ATTN_STORE16(p,v) (*(u32x4*)(p)=(v))
#endif
template<int THRL> __device__ __forceinline__ void attn_unit(const bf16*Qrow0,const bf16*__restrict__ Kh,const bf16*__restrict__ Vh,bf16*Orow0,const int NT,char*shm){
  const int tid=threadIdx.x,lane=tid&63,r32=lane&31,hi=lane>>5; const int wid=__builtin_amdgcn_readfirstlane(tid>>6);
  const bf16*Qw=Qrow0+(long)(wid*QBLK)*QP;
  const unsigned lds0=(unsigned)(uintptr_t)shm;
  float*wsf=(float*)(shm+LDS_WS)+wid*64;
  const bf16*ksrc=Kh+(long)lane*KP+wid*8;
  const bf16*vsrc=Vh+(long)(16*(wid&3)+(lane>>2))*KP+(wid>>2)*32+(lane&3)*8;
  const unsigned kdst=lds0+LDS_K+wid*1024, vdst=lds0+LDS_V+wid*1024;
  #define DMA_K(t,slot) glds16(ksrc+(long)(t)*KVBLK*KP,(unsigned)__builtin_amdgcn_readfirstlane(kdst+(slot)))
  #define DMA_V(t,slot) glds16(vsrc+(long)(t)*KVBLK*KP,(unsigned)__builtin_amdgcn_readfirstlane(vdst+(slot)))
  const int vb0=(int)(lds0+LDS_V)+((lane>>4)&1)*32+(lane&3)*8+(4*hi+((lane&15)>>2))*64;
  const char*Kbase=shm+LDS_K; bf16x8 kf[8];
  const lds_cptr shm3=(lds_cptr)shm; const lds_cptr kp0=shm3+LDS_K+hi*1024+r32*16; const lds_cptr vp0=shm3+LDS_V+((lane>>4)&1)*32+(lane&3)*8+(4*hi+((lane&15)>>2))*64;
  DMA_K(0,0);DMA_V(0,0);DMA_K(1,SLOTB);
  bf16x8 qr[4];
  #pragma unroll
  for(int d0=0;d0<4;++d0)qr[d0]=*reinterpret_cast<const bf16x8*>(&Qw[(long)r32*QP+d0*16+hi*8]);
  float mhat=0.f,l_reg=0.f;f32x16 o[2];o[0]=f32x16{};o[1]=f32x16{};f32x16 negm=f32x16{};asm volatile("":"+v"(negm));
  #define CMASK(P0,P1,t) do{}while(0)
  bool resc=false;
  #define START(P0,P1) do{ const float rm=rowmax(P0,P1); resc=false; \
    { const float dl=rm; mhat=fadd_s(mhat,dl); \
      _Pragma("unroll") for(int r=0;r<16;++r){P0[r]=fsub_s(P0[r],dl);P1[r]=fsub_s(P1[r],dl);} \
      _Pragma("unroll") for(int r=0;r<16;++r)negm[r]=-mhat; asm volatile("":"+v"(negm)); } \
    _Pragma("unroll") for(int r=0;r<16;++r)P0[r]=__builtin_amdgcn_exp2f(P0[r]); }while(0)
  #define RESC() do{ if(resc){ asm volatile("s_waitcnt lgkmcnt(0)":::"memory"); \
      _Pragma("unroll") for(int d_=0;d_<2;++d_) _Pragma("unroll") for(int r=0;r<16;++r)o[d_][r]*=wsf[crow(r,hi)]; } }while(0)
  f32x16 pA0,pA1,pB0,pB1;
  int sl_prev=0,sl_cur=0,sl_next=SLOTB;
  #define ROT() do{sl_prev=sl_cur;sl_cur=sl_next;sl_next=(sl_next==(NSLOT-1)*SLOTB)?0:sl_next+SLOTB;}while(0)
  DMA_K(2,2*SLOTB);
  WAIT_BAR(3);
  qkt(pA0,pA1,Kbase,qr,negm,r32,hi);asm volatile("s_nop 15\n\ts_nop 7":"+v"(pA0),"+v"(pA1));CMASK(pA0,pA1,0);
  START(pA0,pA1);
  _Pragma("unroll") for(int r=0;r<16;++r)pA1[r]=__builtin_amdgcn_exp2f(pA1[r]);
  WAIT_BAR(0);
  DMA_K(3,0);DMA_V(1,SLOTB);
  ROT();
  kload8(kf,kp0+sl_cur);
  WAIT_BAR(2);
  s16x4 vlo[8],vhi[8]; u32x4 pw0,pw1,pw2,pw3;
  #define PKW(P,B) cvtpk_s(P[B],P[B+1])
  #define PAF(k) __builtin_bit_cast(bf16x8,pw##k)
  #define VFR(i) (bf16x8){vlo[i][0],vlo[i][1],vlo[i][2],vlo[i][3],vhi[i][0],vhi[i][1],vhi[i][2],vhi[i][3]}
  #define PIN(x) asm volatile("":"+v"(x))
  #define MX3(a,b,c) __builtin_fmaxf(__builtin_fmaxf((a),(b)),(c))
  #define GAPA(MF,A0,A1,A2,A3,W0,W1,PW) do{ MF; sacc+=A0; sacc+=A1; sacc+=A2; sacc+=A3; PIN(sacc); W0; W1; PIN(PW); SBAR(); }while(0)
  #define EX(v) __builtin_amdgcn_exp2f(v)
  #define GAPB(MF,X,B) do{ MF; X[B]=EX(X[B]); X[B+1]=EX(X[B+1]); X[B+2]=EX(X[B+2]); X[B+3]=EX(X[B+3]); PIN(X); SBAR(); }while(0)
  #define VRD(i) do{ vlo[i]=vtr(vp_+(((i)>>2)*4096+((i)&3)*1024)); vhi[i]=vtr(vp_+(((i)>>2)*4096+((i)&3)*1024+512)); }while(0)
  #define KRD(G,j) do{ if(G){ kload2(kf,kp0+sl_next,j); SBAR(); } }while(0)
  #define STEP(C0,C1,P0,P1,t,GK,GV,GL) do{ SBAR(); \
    const lds_cptr vp_=vp0+sl_prev; \
    VRD(0); SBAR(); float sacc=(P0[0]+P0[1]); \
    GAPA(C0=__builtin_amdgcn_mfma_f32_32x32x16_bf16(kf[0],qr[0],negm,0,0,0), P0[2],P0[3],P0[4],P0[5],     pw0[0]=PKW(P0,0), pw0[1]=PKW(P0,2), pw0); \
    VRD(4); SBAR(); GAPA(C1=__builtin_amdgcn_mfma_f32_32x32x16_bf16(kf[1],qr[0],negm,0,0,0), P0[6],P0[7],P0[8],P0[9],     pw0[2]=PKW(P0,4), pw0[3]=PKW(P0,6), pw0); \
    VRD(1); SBAR(); GAPA(C0=__builtin_amdgcn_mfma_f32_32x32x16_bf16(kf[2],qr[1],C0,0,0,0),   P0[10],P0[11],P0[12],P0[13], pw1[0]=PKW(P0,8), pw1[1]=PKW(P0,10), pw1); \
    VRD(5); SBAR(); GAPA(C1=__builtin_amdgcn_mfma_f32_32x32x16_bf16(kf[3],qr[1],C1,0,0,0),   P0[14],P0[15],P1[0],P1[1],   pw1[2]=PKW(P0,12),pw1[3]=PKW(P0,14), pw1); \
    VRD(2); SBAR(); GAPA(C0=__builtin_amdgcn_mfma_f32_32x32x16_bf16(kf[4],qr[2],C0,0,0,0),   P1[2],P1[3],P1[4],P1[5],     pw2[0]=PKW(P1,0), pw2[1]=PKW(P1,2), pw2); \
    VRD(6); SBAR(); GAPA(C1=__builtin_amdgcn_mfma_f32_32x32x16_bf16(kf[5],qr[2],C1,0,0,0),   P1[6],P1[7],P1[8],P1[9],     pw2[2]=PKW(P1,4), pw2[3]=PKW(P1,6), pw2); \
    VRD(3); SBAR(); GAPA(C0=__builtin_amdgcn_mfma_f32_32x32x16_bf16(kf[6],qr[3],C0,0,0,0),   P1[10],P1[11],P1[12],P1[13], pw3[0]=PKW(P1,8), pw3[1]=PKW(P1,10), pw3); \
    VRD(7); SBAR(); GAPA(C1=__builtin_amdgcn_mfma_f32_32x32x16_bf16(kf[7],qr[3],C1,0,0,0),   P1[14],P1[15],0.f,0.f,       pw3[2]=PKW(P1,12),pw3[3]=PKW(P1,14), pw3); \
    l_reg+=sacc; \
    if(GK){DMA_K((t)+3,sl_cur);} if(GV){DMA_V((t)+1,sl_next);} \
    CMASK(C0,C1,t); \
    { float a=MX3(C0[0],C0[1],C1[0]),b=MX3(C0[2],C0[3],C1[1]); a=MX3(a,C1[2],C1[3]); \
      _Pragma("unroll") for(int r=4;r<16;r+=4){a=MX3(a,C0[r],C0[r+1]);b=MX3(b,C0[r+2],C0[r+3]);a=MX3(a,C1[r],C1[r+1]);b=MX3(b,C1[r+2],C1[r+3]);} \
      float rm=__builtin_fmaxf(a,b); { auto rr=__builtin_amdgcn_permlane32_swap(__float_as_uint(rm),__float_as_uint(rm),false,false); rm=__builtin_fmaxf(__uint_as_float(rr[0]),__uint_as_float(rr[1])); } \
      resc=false; \
      if(__builtin_expect(__any(rm>(float)THRL),0)){ const float dl=__builtin_fmaxf(rm,0.f); mhat+=dl; \
        _Pragma("unroll") for(int r=0;r<16;++r){C0[r]-=dl;C1[r]-=dl;} \
        _Pragma("unroll") for(int r=0;r<16;++r)negm[r]=-mhat; asm volatile("":"+v"(negm)); \
        const float f=__builtin_amdgcn_exp2f(-dl); l_reg*=f; if(hi==0)wsf[r32]=f; resc=true; } } \
    SBAR(); \
    GAPB(o[0]=__builtin_amdgcn_mfma_f32_32x32x16_bf16(PAF(0),VFR(0),o[0],0,0,0), C0,0); \
    GAPB(o[1]=__builtin_amdgcn_mfma_f32_32x32x16_bf16(PAF(0),VFR(4),o[1],0,0,0), C0,4); \
    KRD(GL,0); GAPB(o[0]=__builtin_amdgcn_mfma_f32_32x32x16_bf16(PAF(1),VFR(1),o[0],0,0,0), C0,8); \
    KRD(GL,1); GAPB(o[1]=__builtin_amdgcn_mfma_f32_32x32x16_bf16(PAF(1),VFR(5),o[1],0,0,0), C0,12); \
    KRD(GL,2); GAPB(o[0]=__builtin_amdgcn_mfma_f32_32x32x16_bf16(PAF(2),VFR(2),o[0],0,0,0), C1,0); \
    KRD(GL,3); GAPB(o[1]=__builtin_amdgcn_mfma_f32_32x32x16_bf16(PAF(2),VFR(6),o[1],0,0,0), C1,4); \
    GAPB(o[0]=__builtin_amdgcn_mfma_f32_32x32x16_bf16(PAF(3),VFR(3),o[0],0,0,0), C1,8); \
    GAPB(o[1]=__builtin_amdgcn_mfma_f32_32x32x16_bf16(PAF(3),VFR(7),o[1],0,0,0), C1,12); \
    }while(0)
  int t=1;
  #undef CMASK
  #define CMASK(P0,P1,t) do{}while(0)
  for(;t+5<NT;t+=2){
    STEP(pB0,pB1,pA0,pA1,t,true,true,true);     WAIT_BAR(2); RESC(); ROT();
    STEP(pA0,pA1,pB0,pB1,t+1,true,true,true);   WAIT_BAR(2); RESC(); ROT();
  }
  #undef CMASK
  #define CMASK(P0,P1,t) do{}while(0)
  #define ENDW(tt) do{ if((tt)+3<NT){WAIT_BAR(2);} else if((tt)+2<NT){WAIT_BAR(1);} else {WAIT_BAR(0);} }while(0)
  for(;t+1<NT;t+=2){
    STEP(pB0,pB1,pA0,pA1,t,(t+3<NT),(t+1<NT),(t+1<NT));       ENDW(t);   RESC(); ROT();
    STEP(pA0,pA1,pB0,pB1,t+1,(t+4<NT),(t+2<NT),(t+2<NT));     ENDW(t+1); RESC(); ROT();
  }
  STEP(pB0,pB1,pA0,pA1,NT-1,false,false,false); RESC();
  { float sacc=pB0[0]+pB0[1]; _Pragma("unroll") for(int r=2;r<16;++r)sacc+=pB0[r]; _Pragma("unroll") for(int r=0;r<16;++r)sacc+=pB1[r]; l_reg+=sacc;
    pw0=(u32x4){PKW(pB0,0),PKW(pB0,2),PKW(pB0,4),PKW(pB0,6)};pw1=(u32x4){PKW(pB0,8),PKW(pB0,10),PKW(pB0,12),PKW(pB0,14)};pw2=(u32x4){PKW(pB1,0),PKW(pB1,2),PKW(pB1,4),PKW(pB1,6)};pw3=(u32x4){PKW(pB1,8),PKW(pB1,10),PKW(pB1,12),PKW(pB1,14)};
    SBAR(); pv(o,vb0+sl_cur,PAF(0),PAF(1),PAF(2),PAF(3)); }
  #undef PKW
  #undef PAF
  #undef VFR
  #undef PIN
  #undef MX3
  #undef GAPA
  #undef GAPB
  #undef EX
  #undef VRD
  #undef KRD
  #undef STEP
  #undef ENDW
  {auto rr=__builtin_amdgcn_permlane32_swap(__float_as_uint(l_reg),__float_as_uint(l_reg),false,false);l_reg=__uint_as_float(rr[0])+__uint_as_float(rr[1]);}
  if(hi==0)wsf[32+r32]=l_reg;asm volatile("s_waitcnt lgkmcnt(0)":::"memory");
  float rli[16];
  #pragma unroll
  for(int r=0;r<16;++r)rli[r]=__builtin_amdgcn_rcpf(wsf[32+crow(r,hi)]);
  bf16*Ow=Orow0+(long)(wid*QBLK)*OP;
  { bf16*stg=(bf16*)(shm+LDS_OST)+wid*2048;
    #pragma unroll
    for(int r=0;r<16;++r){const int orow=crow(r,hi);
      #pragma unroll
      for(int d0=0;d0<2;++d0)stg[orow*64+d0*32+r32]=__float2bfloat16(o[d0][r]*rli[r]);}
    asm volatile("s_waitcnt lgkmcnt(0)":::"memory");
    #pragma unroll
    for(int i=0;i<4;++i){const int row=i*8+(lane>>3),ch=lane&7; const u32x4 v=*(const u32x4*)(stg+row*64+ch*8); ATTN_STORE16(Ow+(long)row*OP+ch*8,v);} }
  asm volatile("s_waitcnt lgkmcnt(0)\n\ts_barrier":::"memory");
  #undef DMA_K
  #undef DMA_V
  #undef CMASK
  #undef START
  #undef RESC
  #undef ROT
}
constexpr int ATTN_LDS_BYTES=LDS_BYTES;
#undef SBAR
#undef WAIT_BAR
}

__device__ __forceinline__ void attn_phase_mfma(const Params& p, char* lds) {
    using namespace attn_body;
    unsigned char* ws = p.ws; const bf16* Qb = (const bf16*)(ws + WS_QB); const bf16* Kb = (const bf16*)(ws + WS_KB); const bf16* Vb = (const bf16*)(ws + WS_VB); bf16* Y = (bf16*)(ws + WS_Y);
    const int bid = blockIdx.x, G = gridDim.x; const int vcu = (G % 8 == 0) ? (bid % 8) * (G / 8) + bid / 8 : bid;
    for (int U = vcu; U < 512 + 64; U += G) {
        int b, hq, NT; long qrow;
        if (U < 512) { const int grp = U >> 5, w = U & 31; b = grp >> 1; hq = (grp & 1) * 4 + (w >> 3); qrow = (long)b * SEQ + (w & 7) * 256; NT = KVL / 64; }
        else { const int j = U - 512; b = j >> 3; hq = j & 7; qrow = (long)ML + b * CTX; NT = CTX / 64; }
        const long kvoff = (long)b * KVL * 128 + (hq >> 2) * 64;
        attn_unit<8>(Qb + qrow * 512 + hq * 64, Kb + kvoff, Vb + kvoff, Y + qrow * 1024 + 512 + hq * 64, NT, lds);
    }
}


typedef short s16x4_t __attribute__((ext_vector_type(4)));
typedef float f32x16 __attribute__((ext_vector_type(16)));
template <int L, int P> struct HyCfg {
    static constexpr int WPC = L / (128 * P), CPW = 8 / WPC;
    static constexpr int NSTEP = (L + 96) / 16;
    static constexpr int ROWB = (L + 200) * 2;
    static constexpr int CPLEN = 2 * L + 16;
    static constexpr int CPB = CPLEN * 2 + ((64 - (CPLEN * 2) % 256) + 256) % 256;
    static constexpr int SIGB = CPW * 8 * ROWB, FLTB = CPW * 4 * CPB;
};
template <int L, int P> __device__ __forceinline__ void hy_build_flt(LAS unsigned char* FLT, const float* KF, int cbase, int ord, int tid) {
    using C = HyCfg<L, P>;
    constexpr int NPAIR = C::CPLEN / 2;
    for (int idx = tid; idx < C::CPW * 4 * NPAIR; idx += NTHR) {
        const int chq = idx / NPAIR, pp = idx % NPAIR, q = chq & 3;
        const float* kf = KF + (size_t)(ord * 512 + cbase + (chq >> 2)) * (2 * L);
        const int i0 = 2 * L - 2 * pp + q, i1 = i0 - 1;
        const float v0 = (i0 >= 0 && i0 < 2 * L) ? kf[i0] : 0.f, v1 = (i1 >= 0 && i1 < 2 * L) ? kf[i1] : 0.f;
        *(LAS unsigned*)(FLT + chq * C::CPB + pp * 4) = pk2(v0, v1);
    }
}
template <int L, int P> __device__ __forceinline__ void hyena_unit(const Params& p, LAS unsigned char* lds, const int cbase, const bf16_t* ZT, const float* KF, bf16_t* Y, const int rowbase0) {
    using C = HyCfg<L, P>;
    const int tid = threadIdx.x, lane = tid & 63, wid = __builtin_amdgcn_readfirstlane(tid >> 6), r = lane & 31, h = lane >> 5;
    const int chl = wid / C::WPC, ob = wid % C::WPC, c = cbase + chl, Tw = 128 * P * ob;
    LAS unsigned char* SIG = lds; LAS unsigned char* FLT = lds + C::SIGB;
    __syncthreads();
    for (int idx = tid; idx < C::CPW * 8 * 100; idx += NTHR) { const int row = idx / 100, w = idx % 100; const int e = (w < 48) ? 2 * w : (96 + L + 2 * (w - 48)); *(LAS unsigned*)(SIG + row * C::ROWB + e * 2) = 0u; }
    for (int idx = tid; idx < C::CPW * 8 * (L / 8); idx += NTHR) { const int row = idx / (L / 8), c8 = idx % (L / 8);
        const u32x4 v = *(const u32x4*)(ZT + ((size_t)(cbase * 8 + row)) * L + c8 * 8); *(LAS u32x4*)(SIG + row * C::ROWB + (96 + c8 * 8) * 2) = v; }
    hy_build_flt<L, P>(FLT, KF, cbase, 0, tid);
    __syncthreads();
    const LAS unsigned char* sigp = SIG + (chl * 8 + (r >> 2)) * C::ROWB + (32 * (r & 3) + 8 * h) * 2;
    const LAS unsigned char* fltp = FLT + (chl * 4 + (r & 3)) * C::CPB + (L + 8 * h - 4 * (r >> 2) - Tw - 96 - 128 * (P - 1)) * 2;
#pragma unroll 1
    for (int ord = 0; ord < 2; ++ord) {
        f32x16 acc[P];
#pragma unroll
        for (int q = 0; q < P; ++q)
#pragma unroll
            for (int e = 0; e < 16; ++e) acc[q][e] = 0.f;
#pragma unroll 2
        for (int n = 0; n < C::NSTEP; ++n) {
            const bf16x8 a = *(const LAS bf16x8*)(sigp + 32 * n);
#pragma unroll
            for (int q = 0; q < P; ++q) {
                const s16x4_t lo = *(const LAS s16x4_t*)(fltp + 32 * n + 256 * (P - 1 - q)), hi = *(const LAS s16x4_t*)(fltp + 32 * n + 256 * (P - 1 - q) + 8);
                const bf16x8 b = (bf16x8){lo[0], lo[1], lo[2], lo[3], hi[0], hi[1], hi[2], hi[3]};
                acc[q] = __builtin_amdgcn_mfma_f32_32x32x16_bf16(a, b, acc[q], 0, 0, 0);
            }
        }
        int lt = Tw + r, hh = h; asm volatile("" : "+v"(lt), "+v"(hh));
        const float skip = p.in[I_SKIP][ord * 512 + c];
        const bf16_t* gate = ZT + ((size_t)((ord + 1) * 512 + c) * 8) * L;
        const LAS unsigned char* sv = SIG + (chl * 8 + hh) * C::ROWB + (96 + lt) * 2;
        const int og = hh * L + lt;
#pragma unroll
        for (int q = 0; q < P; ++q) {
#pragma unroll
            for (int e = 0; e < 16; ++e) { const int cb = 2 * (e >> 2), ct = 32 * (e & 3) + 128 * q;
                const float v = bf2f(*(const LAS unsigned short*)(sv + cb * C::ROWB + ct * 2));
                const float g = bf2f(gate[og + cb * L + ct]);
                acc[q][e] = g * (acc[q][e] + skip * v); }
            asm volatile("" ::: "memory");
        }
        if (ord == 0) {
            __syncthreads();
            LAS unsigned char* sw = SIG + (chl * 8 + hh) * C::ROWB + (96 + lt) * 2;
#pragma unroll
            for (int q = 0; q < P; ++q)
#pragma unroll
                for (int e = 0; e < 16; ++e) { const int cb = 2 * (e >> 2), ct = 32 * (e & 3) + 128 * q;
                    *(LAS unsigned short*)(sw + cb * C::ROWB + ct * 2) = (unsigned short)f2bf(acc[q][e]); }
            hy_build_flt<L, P>(FLT, KF, cbase, 1, tid);
            __syncthreads();
        } else {
            bf16_t* yo = Y + (size_t)(rowbase0 + og) * D + c;
#pragma unroll
            for (int q = 0; q < P; ++q) {
#pragma unroll
                for (int e = 0; e < 16; ++e) { const int cb = 2 * (e >> 2), ct = 32 * (e & 3) + 128 * q;
                    yo[(size_t)(cb * L + ct) * D] = (bf16_t)f2bf(acc[q][e]); }
                asm volatile("" ::: "memory");
            }
        }
    }
}
__device__ __forceinline__ void hyena_phase_mfma(const Params& p, LAS unsigned char* lds) {
    unsigned char* ws = p.ws; bf16_t* Y = (bf16_t*)(ws + WS_Y);
    const int bid = blockIdx.x, G = gridDim.x; const int vcu = (G % 8 == 0) ? (bid % 8) * (G / 8) + bid / 8 : bid;
    for (int u = vcu; u < 256; u += G) hyena_unit<SEQ, 4>(p, lds, 2 * u, (const bf16_t*)(ws + WS_ZTL), (const float*)(ws + WS_KFL), Y, 0);
    for (int u = vcu; u < 256; u += G) if ((u & 3) == 0) hyena_unit<CTX, 2>(p, lds, 8 * (u >> 2), (const bf16_t*)(ws + WS_ZTC), (const float*)(ws + WS_KFC), Y, ML);
    __syncthreads();
}

__device__ __forceinline__ void attn_naive(const Params& p, Frame& F) {
    unsigned char* ws = p.ws; const bf16_t* Qb = (const bf16_t*)(ws + WS_QB); const bf16_t* Kb = (const bf16_t*)(ws + WS_KB); const bf16_t* Vb = (const bf16_t*)(ws + WS_VB);
    bf16_t* Y = (bf16_t*)(ws + WS_Y);
    const int gw = F.bid * NWAVES + F.wave, NGW = F.G * NWAVES, lane = F.lane;
    for (int it = gw; it < 2304; it += NGW) {
        int b, h, row, nk;
        if (it < 2048) { b = it >> 8; h = (it >> 5) & 7; row = b * SEQ + (it & 31) * 64 + lane; nk = KVL; }
        else { const int j = it - 2048; b = j >> 5; h = (j >> 2) & 7; row = ML + b * CTX + (j & 3) * 64 + lane; nk = CTX; }
        float q[64], o[64];
#pragma unroll
        for (int c = 0; c < 8; ++c) unpack8(*(const u32x4*)(Qb + (size_t)row * 512 + h * 64 + c * 8), q + c * 8);
#pragma unroll
        for (int d = 0; d < 64; ++d) o[d] = 0.f;
        float m = -3.0e38f, l = 0.f;
        const bf16_t* kp = Kb + (size_t)b * KVL * 128 + (h >> 2) * 64; const bf16_t* vp = Vb + (size_t)b * KVL * 128 + (h >> 2) * 64;
        for (int j = 0; j < nk; ++j) {
            float s = 0.f;
#pragma unroll
            for (int c = 0; c < 8; ++c) { float kk[8]; unpack8(*(const u32x4*)(kp + (size_t)j * 128 + c * 8), kk);
#pragma unroll
                for (int e = 0; e < 8; ++e) s += q[c * 8 + e] * kk[e]; }
            const float mn = fmaxf(m, s), al = exp2f(m - mn), pe = exp2f(s - mn);
            l = l * al + pe; m = mn;
#pragma unroll
            for (int c = 0; c < 8; ++c) { float vv[8]; unpack8(*(const u32x4*)(vp + (size_t)j * 128 + c * 8), vv);
#pragma unroll
                for (int e = 0; e < 8; ++e) o[c * 8 + e] = o[c * 8 + e] * al + pe * vv[e]; }
        }
        const float il = 1.f / l;
#pragma unroll
        for (int c = 0; c < 8; ++c) { float t8[8];
#pragma unroll
            for (int e = 0; e < 8; ++e) t8[e] = o[c * 8 + e] * il;
            *(u32x4*)(Y + (size_t)row * D + 512 + h * 64 + c * 8) = pack8(t8); }
    }
}
template <int L> __device__ __forceinline__ void hyena_naive_unit(const Params& p, Frame& F, int c, int b, const bf16_t* ZT, const float* KF, bf16_t* Y, int rowbase) {
    LAS float* sig = (LAS float*)F.lds; LAS float* flt = sig + L;
    constexpr int NT = (L + NTHR - 1) / NTHR;
    __syncthreads();
    for (int t = F.tid; t < L; t += NTHR) sig[t] = bf2f(ZT[((size_t)c * 8 + b) * L + t]);
#pragma unroll 1
    for (int ord = 0; ord < 2; ++ord) {
        for (int i = F.tid; i < 2 * L; i += NTHR) flt[i] = KF[(size_t)(ord * 512 + c) * (2 * L) + i];
        __syncthreads();
        float acc[NT];
#pragma unroll
        for (int q = 0; q < NT; ++q) acc[q] = 0.f;
        for (int s = 0; s < L; ++s) { const float sv = sig[s];
#pragma unroll
            for (int q = 0; q < NT; ++q) { const int t = F.tid + NTHR * q; if (t < L) acc[q] += flt[L + t - s] * sv; } }
        float vn[NT];
#pragma unroll
        for (int q = 0; q < NT; ++q) { const int t = F.tid + NTHR * q; vn[q] = 0.f;
            if (t < L) { const float xg = bf2f(ZT[((size_t)((ord + 1) * 512 + c) * 8 + b) * L + t]); vn[q] = xg * (acc[q] + p.in[I_SKIP][ord * 512 + c] * sig[t]); } }
        __syncthreads();
#pragma unroll
        for (int q = 0; q < NT; ++q) { const int t = F.tid + NTHR * q; if (t < L) sig[t] = vn[q]; }
        __syncthreads();
    }
    for (int t = F.tid; t < L; t += NTHR) Y[(size_t)(rowbase + t) * D + c] = (bf16_t)f2bf(sig[t]);
}
__device__ __forceinline__ void hyena_naive(const Params& p, Frame& F) {
    unsigned char* ws = p.ws; bf16_t* Y = (bf16_t*)(ws + WS_Y);
    for (int it = F.bid; it < 8192; it += F.G) {
        const bool isc = it >= 4096; const int j = isc ? it - 4096 : it; const int c = j >> 3, b = j & 7;
        if (!isc) hyena_naive_unit<SEQ>(p, F, c, b, (const bf16_t*)(ws + WS_ZTL), (const float*)(ws + WS_KFL), Y, b * SEQ);
        else hyena_naive_unit<CTX>(p, F, c, b, (const bf16_t*)(ws + WS_ZTC), (const float*)(ws + WS_KFC), Y, ML + b * CTX);
    }
}


typedef float f32x4_t __attribute__((ext_vector_type(4)));
__device__ __forceinline__ void s5_mfma(const Params& p, LAS unsigned char* lds) {
    const int tid = threadIdx.x, lane = tid & 63, wid = __builtin_amdgcn_readfirstlane(tid >> 6);
    if (wid >= 2) return;
    unsigned char* ws = p.ws; const bf16_t* U = (const bf16_t*)(ws + WS_U);
    const float* AB = (const float*)(ws + WS_S5AB); const float* BB = (const float*)(ws + WS_S5BB);
    LAS unsigned char* lw = lds + wid * 8192;
    const int j = lane & 31, h = lane >> 5, i16 = lane & 15, kg = lane >> 4;
    for (int task = blockIdx.x * 2 + wid; task < 512; task += gridDim.x * 2) {
        const int dir = task >> 8, g = (task >> 2) & 63, bp = task & 3;
        const int gi0 = (dir * 64 + g) * 64;
        bf16x8 bdrv[4];
#pragma unroll
        for (int jb = 0; jb < 4; ++jb) { const float* src = BB + (jb >> 1) * 131072 + (size_t)(gi0 + j + 32 * (jb & 1)) * 16 + 8 * h;
            const f32x4 x0 = *(const f32x4*)src, x1 = *(const f32x4*)(src + 4); const u32x4 w = {pk2(x0.x, x0.y), pk2(x0.z, x0.w), pk2(x1.x, x1.y), pk2(x1.z, x1.w)};
            bdrv[jb] = __builtin_bit_cast(bf16x8, w); }
        const float ar0 = AB[gi0 + j], ai0 = AB[8192 + gi0 + j], ar1 = AB[gi0 + j + 32], ai1 = AB[8192 + gi0 + j + 32];
        bf16x8 bro[4];
        const float* cre = p.in[I_CRE] + ((size_t)(dir * 64 + g) * 16 + i16) * 64; const float* cim = p.in[I_CIM] + ((size_t)(dir * 64 + g) * 16 + i16) * 64;
#pragma unroll
        for (int ks = 0; ks < 4; ++ks) { float v[8];
#pragma unroll
            for (int e = 0; e < 8; ++e) { const int sc = 32 * ks + 8 * kg + e; const int n = (sc >> 2) + 32 * ((sc >> 1) & 1); v[e] = (sc & 1) ? -cim[n] : cre[n]; }
            const u32x4 w = pack8(v); bro[ks] = __builtin_bit_cast(bf16x8, w); }
        float* YO = (float*)(ws + (dir == 0 ? WS_YF : WS_YB));
        const int abeta = (j >> 2) & 1, atau = (j & 3) + 4 * (j >> 3), ab = 2 * bp + abeta;
        const bf16_t* ug = U + (size_t)g * MT * 16 + 8 * h;
        auto a_addr = [&](int ch) -> const bf16_t* {
            const bool isc = ch < 16; const int cl = isc ? ch : ch - 16; const int Ls = isc ? CTX : SEQ; const int st = 16 * cl + atau; const int t = dir == 0 ? st : Ls - 1 - st;
            const int row = isc ? ML + ab * CTX + t : ab * SEQ + t; return ug + (size_t)row * 16; };
        bf16x8 a_cur = *(const bf16x8*)a_addr(0);
        float sr0 = 0.f, si0 = 0.f, sr1 = 0.f, si1 = 0.f;
        const int xj = j >> 1;
        LAS unsigned char* wbase = lw + h * 4096 + ((j & 1) << 3);
#pragma unroll 1
        for (int ch = 0; ch < 144; ++ch) {
            const bf16x8 a_nxt = *(const bf16x8*)a_addr(ch + 1 < 144 ? ch + 1 : ch);
            const f32x16 z16 = {0.f, 0.f, 0.f, 0.f, 0.f, 0.f, 0.f, 0.f, 0.f, 0.f, 0.f, 0.f, 0.f, 0.f, 0.f, 0.f};
            const f32x16 d0 = __builtin_amdgcn_mfma_f32_32x32x16_bf16(a_cur, bdrv[0], z16, 0, 0, 0);
            const f32x16 d1 = __builtin_amdgcn_mfma_f32_32x32x16_bf16(a_cur, bdrv[1], z16, 0, 0, 0);
            const f32x16 d2 = __builtin_amdgcn_mfma_f32_32x32x16_bf16(a_cur, bdrv[2], z16, 0, 0, 0);
            const f32x16 d3 = __builtin_amdgcn_mfma_f32_32x32x16_bf16(a_cur, bdrv[3], z16, 0, 0, 0);
            const bool lat = ch >= 16;
#pragma unroll
            for (int e = 0; e < 16; ++e) {
                const float nr0 = ar0 * sr0 - ai0 * si0 + d0[e], ni0 = ar0 * si0 + ai0 * sr0 + d2[e];
                const float nr1 = ar1 * sr1 - ai1 * si1 + d1[e], ni1 = ar1 * si1 + ai1 * sr1 + d3[e];
                sr0 = nr0; si0 = ni0; sr1 = nr1; si1 = ni1;
                if (lat) { const u32x2 w = {pk2(sr0, si0), pk2(sr1, si1)}; *(LAS u32x2*)(wbase + e * 256 + ((xj ^ e) << 4)) = w; }
            }
            if (lat) {
                asm volatile("s_waitcnt lgkmcnt(0)" ::: "memory");
                const int cl = ch - 16;
#pragma unroll
                for (int rb = 0; rb < 2; ++rb) {
                    f32x4 y = {0.f, 0.f, 0.f, 0.f};
#pragma unroll
                    for (int ks = 0; ks < 4; ++ks) { const bf16x8 sa = *(const LAS bf16x8*)(lw + (16 * rb + i16) * 256 + (((4 * ks + kg) ^ i16) << 4));
                        y = __builtin_amdgcn_mfma_f32_16x16x32_bf16(sa, bro[ks], y, 0, 0, 0); }
#pragma unroll
                    for (int e2 = 0; e2 < 4; ++e2) { const int st = 16 * cl + 4 * kg + e2; const int t = dir == 0 ? st : SEQ - 1 - st;
                        YO[(size_t)((2 * bp + rb) * SEQ + t) * D + g * 16 + i16] = y[e2]; }
                }
                asm volatile("s_waitcnt lgkmcnt(0)" ::: "memory");
            }
            a_cur = a_nxt;
        }
    }
}

__device__ __forceinline__ void s5_naive(const Params& p, Frame& F) {
    unsigned char* ws = p.ws; const bf16_t* U = (const bf16_t*)(ws + WS_U);
    const float* AB = (const float*)(ws + WS_S5AB); const float* BB = (const float*)(ws + WS_S5BB);
    const int gw = F.bid * NWAVES + F.wave, NGW = F.G * NWAVES, n = F.lane;
    for (int it = gw; it < 1024; it += NGW) {
        const int dir = it >> 9, b = (it >> 6) & 7, g = it & 63; const int gi = (dir * 64 + g) * 64 + n;
        const float ar = AB[gi], ai = AB[8192 + gi];
        float br[16], bi[16], cr[16], ci[16];
#pragma unroll
        for (int k = 0; k < 16; ++k) { br[k] = BB[gi * 16 + k]; bi[k] = BB[131072 + gi * 16 + k];
            cr[k] = p.in[I_CRE][((size_t)(dir * 64 + g) * 16 + k) * 64 + n]; ci[k] = p.in[I_CIM][((size_t)(dir * 64 + g) * 16 + k) * 64 + n]; }
        float* YO = (float*)(ws + (dir == 0 ? WS_YF : WS_YB));
        float sr = 0.f, si = 0.f;
        for (int step = 0; step < KVL; ++step) {
            const bool isc = step < CTX; const int i = isc ? step : step - CTX; const int L = isc ? CTX : SEQ;
            const int t = dir == 0 ? i : L - 1 - i; const int row = isc ? ML + b * CTX + t : b * SEQ + t;
            float u[16]; const bf16_t* up = U + ((size_t)g * MT + row) * 16;
            unpack8(*(const u32x4*)up, u); unpack8(*(const u32x4*)(up + 8), u + 8);
            float bur = 0.f, bui = 0.f;
#pragma unroll
            for (int k = 0; k < 16; ++k) { bur += br[k] * u[k]; bui += bi[k] * u[k]; }
            const float nr = ar * sr - ai * si + bur, ni = ar * si + ai * sr + bui; sr = nr; si = ni;
            if (!isc) {
                float pv[16];
#pragma unroll
                for (int k = 0; k < 16; ++k) pv[k] = cr[k] * sr - ci[k] * si;
                float q8[8], q4[4], q2[2];
#pragma unroll
                for (int k = 0; k < 8; ++k) { const float send = (n & 32) ? pv[k] : pv[k + 8], keep = (n & 32) ? pv[k + 8] : pv[k]; q8[k] = keep + __shfl_xor(send, 32); }
#pragma unroll
                for (int k = 0; k < 4; ++k) { const float send = (n & 16) ? q8[k] : q8[k + 4], keep = (n & 16) ? q8[k + 4] : q8[k]; q4[k] = keep + __shfl_xor(send, 16); }
#pragma unroll
                for (int k = 0; k < 2; ++k) { const float send = (n & 8) ? q4[k] : q4[k + 2], keep = (n & 8) ? q4[k + 2] : q4[k]; q2[k] = keep + __shfl_xor(send, 8); }
                const float send = (n & 4) ? q2[0] : q2[1], keep = (n & 4) ? q2[1] : q2[0];
                float y = keep + __shfl_xor(send, 4);
                y += __shfl_xor(y, 2); y += __shfl_xor(y, 1);
                if ((n & 3) == 0) YO[(size_t)row * D + g * 16 + (n >> 2)] = y;
            }
        }
    }
}
__device__ __forceinline__ void phase_p8b(const Params& p, Frame& F) {
    unsigned char* ws = p.ws; const float* YF = (const float*)(ws + WS_YF); const float* YB = (const float*)(ws + WS_YB); const bf16_t* U = (const bf16_t*)(ws + WS_U); bf16_t* Z = (bf16_t*)(ws + WS_Z);
    const int gt = F.bid * NTHR + F.tid, NGT = F.G * NTHR;
    for (int i = gt; i < ML * (D / 8); i += NGT) {
        const int row = i >> 7, col = (i & 127) * 8;
        const f32x4 a0 = *(const f32x4*)(YF + (size_t)row * D + col), a1 = *(const f32x4*)(YF + (size_t)row * D + col + 4);
        const f32x4 b0 = *(const f32x4*)(YB + (size_t)row * D + col), b1 = *(const f32x4*)(YB + (size_t)row * D + col + 4);
        float u[8]; unpack8(*(const u32x4*)(U + ((size_t)(col >> 4) * MT + row) * 16 + (col & 15)), u);
        const f32x4 d0 = *(const f32x4*)(p.in[I_S5D] + col), d1 = *(const f32x4*)(p.in[I_S5D] + col + 4);
        float o[8];
        o[0] = a0.x + b0.x + d0.x * u[0]; o[1] = a0.y + b0.y + d0.y * u[1]; o[2] = a0.z + b0.z + d0.z * u[2]; o[3] = a0.w + b0.w + d0.w * u[3];
        o[4] = a1.x + b1.x + d1.x * u[4]; o[5] = a1.y + b1.y + d1.y * u[5]; o[6] = a1.z + b1.z + d1.z * u[6]; o[7] = a1.w + b1.w + d1.w * u[7];
#pragma unroll
        for (int e = 0; e < 8; ++e) o[e] = gelu_tanh(o[e]);
        *(u32x4*)(Z + (size_t)row * D + col) = pack8(o);
    }
}
__device__ __forceinline__ void fix_tokpos(const Params& p, Frame& F, const LAS int* tab) {
    int* tokpos = (int*)(p.ws + WS_ROUTE) + 8 * 16384;
    const int gt = F.bid * NTHR + F.tid, NGT = F.G * NTHR;
    for (int i = gt; i < 2 * ML; i += NGT) { const int v = tokpos[i]; tokpos[i] = tab[8 + (v >> 16)] + (v & 0xffff); }
}


#define XB_TMO      128
#define XB_XCNT(j)  (256  + 64 * (j))
#define XB_XSUB(j)  (1280 + 64 * (j))
#define XB_XGEN(j)  (2304 + 64 * (j))
#define XB_TOP      3328
#define XB_TOPGEN   3392
#define XCD_BAR_WORDS 3456
#define XB_SPIN_CAP (1u << 18)
__device__ __forceinline__ unsigned xb_ld(unsigned* p)              { return __hip_atomic_load(p, __ATOMIC_RELAXED, __HIP_MEMORY_SCOPE_AGENT); }
__device__ __forceinline__ unsigned xb_add(unsigned* p, unsigned v) { return __hip_atomic_fetch_add(p, v, __ATOMIC_RELAXED, __HIP_MEMORY_SCOPE_AGENT); }
__device__ __forceinline__ unsigned xb_xcc_id() { return (unsigned)__builtin_amdgcn_s_getreg((3 << 11) | 20) & 0xFu; }
#define XB_SPIN(cond, bar) do { unsigned _sp = 0; while (cond) { __builtin_amdgcn_s_sleep(1); \
    if ((++_sp & 255u) == 0u) { if (xb_ld(&(bar)[XB_TMO])) break; if (_sp > XB_SPIN_CAP) { atomicAdd(&(bar)[XB_TMO], 1u); break; } } } } while (0)
struct XcdBarrier { unsigned* bar; unsigned x; volatile LAS unsigned* st; };
__device__ __forceinline__ XcdBarrier xcd_barrier_post(unsigned* bar, volatile LAS unsigned* st) {
    XcdBarrier b; b.bar = bar; b.x = xb_xcc_id(); b.st = st;
    if (threadIdx.x == 0) (void)xb_add(&bar[XB_XCNT(b.x)], 1u);
    return b;
}
__device__ __forceinline__ void xcd_barrier_complete(unsigned* bar, unsigned x, unsigned& nloc, unsigned& nx) {
    const unsigned G = gridDim.x * gridDim.y * gridDim.z;
    unsigned sum, cnt, mine, sp = 0u;
    for (;;) {
        sum = 0u; cnt = 0u; mine = 0u;
#pragma unroll
        for (unsigned j = 0; j < 16; ++j) { const unsigned c = xb_ld(&bar[XB_XCNT(j)]); sum += c; cnt += (c > 0u) ? 1u : 0u; mine = (j == x) ? c : mine; }
        if (sum == G) break;
        __builtin_amdgcn_s_sleep(1);
        if ((++sp & 255u) == 0u) { if (xb_ld(&bar[XB_TMO])) break; if (sp > XB_SPIN_CAP) { atomicAdd(&bar[XB_TMO], 1u); break; } }
    }
    nloc = mine > 0u ? mine : 1u; nx = cnt > 0u ? cnt : 1u;
}
__device__ __forceinline__ void xcd_barrier(const XcdBarrier& b) {
    asm volatile("s_waitcnt vmcnt(0)" ::: "memory");
    __syncthreads();
    if (threadIdx.x == 0) {
        unsigned* bar = b.bar;
        __builtin_amdgcn_s_waitcnt(0);
        unsigned nloc = b.st[0], nx = b.st[1];
        if (nloc == 0u) { xcd_barrier_complete(bar, b.x, nloc, nx); b.st[0] = nloc; b.st[1] = nx; }
        const unsigned old = xb_add(&bar[XB_XSUB(b.x)], 1u);
        const unsigned gen = old / nloc;
        if (old + 1u == (gen + 1u) * nloc) {
            __builtin_amdgcn_fence(__ATOMIC_RELEASE, "agent");
            asm volatile("s_waitcnt vmcnt(0)" ::: "memory");
            const unsigned og = xb_add(&bar[XB_TOP], 1u);
            const unsigned tg = og / nx;
            if (og + 1u == (tg + 1u) * nx) xb_add(&bar[XB_TOPGEN], 1u);
            else XB_SPIN(xb_ld(&bar[XB_TOPGEN]) == tg, bar);
            __builtin_amdgcn_fence(__ATOMIC_ACQUIRE, "agent");
            xb_add(&bar[XB_XGEN(b.x)], 1u);
            asm volatile("s_waitcnt vmcnt(0)" ::: "memory");
        } else {
            XB_SPIN(xb_ld(&bar[XB_XGEN(b.x)]) == gen, bar);
            __builtin_amdgcn_fence(__ATOMIC_ACQUIRE, "agent");
            asm volatile("s_waitcnt vmcnt(0)" ::: "memory");
        }
    }
    __syncthreads();
}

constexpr int LDS_BYTES = 147456;
constexpr int NPHASE = 17;
template <int LO, int HI> __global__ void __launch_bounds__(NTHR, 2) mk_fwd(Params p) {
    extern __shared__ __attribute__((aligned(16))) unsigned char lds[];
#define MKFRAME() Frame F; { int t_ = threadIdx.x; asm volatile("" : "+v"(t_)); F.lds = (LAS unsigned char*)lds; F.tid = t_; F.lane = t_ & 63; F.wave = __builtin_amdgcn_readfirstlane(t_ >> 6); F.G = gridDim.x; F.bid = blockIdx.x; }
    unsigned char* ws = p.ws;
#define IN(k) (LO <= (k) && (k) < HI)
#define GEMM_CALL(A_, B_, K_, S_, E_, F_) pg8::gemm_phase(F.lds, (A_), (B_), (K_), (S_), (E_))
#define SEAM(k) do { if (IN(k) && IN((k) + 1)) xcd_barrier(bar); } while (0)
    volatile LAS unsigned* bst = (volatile LAS unsigned*)((LAS unsigned char*)lds + LDS_BYTES - 64);
    XcdBarrier bar; bar.bar = (unsigned*)(ws + WS_CTL) + CW_BAR; bar.x = 0; bar.st = bst;
    if (HI - LO > 1) { if (threadIdx.x < 4) bst[threadIdx.x] = 0u; __syncthreads(); bar = xcd_barrier_post((unsigned*)(ws + WS_CTL) + CW_BAR, bst); }
    if (IN(0)) { MKFRAME(); phase_p0a(p, F); }
    SEAM(0);
    if (IN(1)) { MKFRAME(); norm_pass<0>(p, F); }
    SEAM(1);
    if (IN(2)) { MKFRAME(); { DenseSched S{MT / 256, INEV / 256, F.G, F.bid}; EpiBf16 E{(bf16_t*)(ws + WS_P), INEV};
        GEMM_CALL((const bf16_t*)(ws + WS_XN), (const bf16_t*)(ws + WS_W0IN), D, S, E, F); } }
    SEAM(2);
    if (IN(3)) { MKFRAME(); phase_p2(p, F); }
    SEAM(3);
    if (IN(4)) { MKFRAME(); {
#ifndef HY_ONLY
        attn_phase_mfma(p, (char*)lds);
#endif
        hyena_phase_mfma(p, F.lds); } }
    SEAM(4);
    if (IN(5)) { MKFRAME(); { DenseSched S{MT / 256, D / 256, F.G, F.bid}; EpiF32 E{(float*)(ws + WS_R), D};
        GEMM_CALL((const bf16_t*)(ws + WS_Y), (const bf16_t*)(ws + WS_W0OUT), D, S, E, F); } }
    SEAM(5);
    if (IN(6)) { MKFRAME(); norm_pass<1>(p, F); }
    SEAM(6);
    if (IN(7)) { MKFRAME(); { DenseSched S{MT / 256, 2 * DFF / 256, F.G, F.bid}; EpiPair<0> E{(void*)(ws + WS_H), DFF};
        GEMM_CALL((const bf16_t*)(ws + WS_XN), (const bf16_t*)(ws + WS_W0GU), D, S, E, F); } }
    SEAM(7);
    if (IN(8)) { MKFRAME(); { DenseSched S{MT / 256, D / 256, F.G, F.bid}; EpiF32 E{(float*)(ws + WS_R), D};
        GEMM_CALL((const bf16_t*)(ws + WS_H), (const bf16_t*)(ws + WS_W0DN), DFF, S, E, F); } }
    SEAM(8);
    if (IN(9)) { MKFRAME(); norm_pass<2>(p, F); }
    SEAM(9);
    if (IN(10)) { MKFRAME(); { DenseSched S{MT / 256, D / 256, F.G, F.bid}; EpiGroupMajor E{(bf16_t*)(ws + WS_U)};
        GEMM_CALL((const bf16_t*)(ws + WS_XN), (const bf16_t*)(ws + WS_W1IN), D, S, E, F); } }
    SEAM(10);
    if (IN(11)) { MKFRAME(); s5_mfma(p, F.lds); }
    SEAM(11);
    if (IN(12)) { MKFRAME(); phase_p8b(p, F); }
    SEAM(12);
    if (IN(13)) { MKFRAME(); { DenseSched S{ML / 256, 2 * D / 256, F.G, F.bid}; EpiPair<1> E{(void*)(ws + WS_R), D};
        GEMM_CALL((const bf16_t*)(ws + WS_Z), (const bf16_t*)(ws + WS_WGLU), D, S, E, F); } }
    SEAM(13);
    if (IN(14)) { MKFRAME(); norm_pass<3>(p, F); }
    SEAM(14);
    if (IN(15)) { MKFRAME(); { LAS int* tab = (LAS int*)(F.lds + 140 * 1024); moe_table(p, F, tab);
        MoeSched S{tab, (const int*)(ws + WS_ROUTE), 2 * DFE / 256, F.G, F.bid, true, 2 * DFE}; EpiPair<0> E{(void*)(ws + WS_H2), DFE};
        GEMM_CALL((const bf16_t*)(ws + WS_XN), (const bf16_t*)(ws + WS_WMGU), D, S, E, F); } }
    SEAM(15);
    if (IN(16)) { MKFRAME(); { LAS int* tab = (LAS int*)(F.lds + 140 * 1024); moe_table(p, F, tab);
        MoeSched S{tab, (const int*)(ws + WS_ROUTE), D / 256, F.G, F.bid, false, D}; EpiBf16 E{(bf16_t*)(ws + WS_Y2), D};
        GEMM_CALL((const bf16_t*)(ws + WS_H2), (const bf16_t*)(ws + WS_WMDN), DFE, S, E, F);
        fix_tokpos(p, F, tab); } }
    SEAM(16);
    if (IN(17)) { MKFRAME(); norm_pass<4>(p, F); }
#undef IN
#undef SEAM
#undef MKFRAME
}

extern "C" void kernel_launch(void* const* d_in, const int* in_sizes, int n_in, void* d_out, int out_size, void* d_ws, size_t ws_size, hipStream_t stream) {
    static int grid = 0;
    if (grid == 0) {
        if (n_in != 41 || out_size != ML * D || ws_size < WS_END) { fprintf(stderr, "kernel_launch: unexpected shapes (n_in %d out %d ws %zu, need %zu)\n", n_in, out_size, ws_size, (size_t)WS_END); grid = -1; return; }
        int dev = 0, cus = 0; (void)hipGetDevice(&dev); (void)hipDeviceGetAttribute(&cus, hipDeviceAttributeMultiprocessorCount, dev);
        grid = cus > 0 ? cus : 256;
    }
    if (grid < 0) return;
    (void)hipMemsetAsync((char*)d_ws + WS_CTL, 0, CTL_ZERO_BYTES, stream);
    Params p{};
    for (int i = 0; i < 41; ++i) p.in[i] = (const float*)d_in[i];
    p.out = (float*)d_out; p.ws = (unsigned char*)d_ws;
static bool once = false;
    if (!once) { (void)hipFuncSetAttribute((const void*)mk_fwd<0, NPHASE + 1>, hipFuncAttributeMaxDynamicSharedMemorySize, LDS_BYTES); once = true; }
    hipLaunchKernelGGL((mk_fwd<0, NPHASE + 1>), dim3(grid), dim3(NTHR), LDS_BYTES, stream, p);
}
#ifdef PERPHASE
void* perphase_refs[] = { (void*)mk_fwd<2,3>, (void*)mk_fwd<5,6>, (void*)mk_fwd<7,8>, (void*)mk_fwd<8,9>, (void*)mk_fwd<10,11>, (void*)mk_fwd<13,14>, (void*)mk_fwd<15,16>, (void*)mk_fwd<16,17>, (void*)mk_fwd<0,1>, (void*)mk_fwd<3,4>, (void*)mk_fwd<4,5>, (void*)mk_fwd<11,12>, (void*)mk_fwd<14,15> };
#endif
```
